# Optimizing an MI355X kernel written in HIP

```python
import jax, jax.numpy as jnp
from jax import lax
import numpy as np

D_MODEL = 1024
BATCH = 8
SEQ = 2048
DEPTH = 1

CTX_LEN = 256
GRID_W = 64
D_CONV = D_MODEL
CONV_K = 3
D_LSTM = D_MODEL
N_HEADS = 8
HEAD_DIM = D_LSTM // N_HEADS
CHUNK = 64
EPS = 1e-6
F_BIAS_LO = 3.0
F_BIAS_HI = 6.0
STATE_COLS = 3 * D_LSTM + 4 * N_HEADS
N_IN = STATE_COLS + 2 * D_LSTM + 4 * D_CONV + 2 * D_MODEL

kernel_name = "hybrid_conv_mlstm_prefix_block"


def _split_sizes(a, sizes):
    idx, acc = [], 0
    for s in sizes[:-1]:
        acc += s
        idx.append(acc)
    return jnp.split(a, idx, axis=-1)


def rmsnorm(a, g):
    af = a.astype(jnp.float32)
    y = af * lax.rsqrt(jnp.mean(af * af, axis=-1, keepdims=True) + EPS) * g.astype(jnp.float32)
    return y.astype(a.dtype)


def dwconv3(u, w, b):
    up = jnp.pad(u, [(0, 0)] * (u.ndim - 2) + [(1, 1), (0, 0)])
    return w[0] * up[..., :-2, :] + w[1] * up[..., 1:-1, :] + w[2] * up[..., 2:, :] + b


def mlstm_scan(q, k, v, i_pre, logf, state, emit):
    bsz, nh, length, dh = q.shape
    nc = length // CHUNK

    def chunks(a):
        return jnp.moveaxis(a.reshape(bsz, nh, nc, CHUNK, *a.shape[3:]), 2, 0)

    tri = jnp.tril(jnp.ones((CHUNK, CHUNK), dtype=bool))

    def step(carry, inp):
        C, n, m = carry
        qc, kc, vc, ic, fc = inp
        b = jnp.cumsum(fc, axis=-1)
        b_last = b[..., -1]
        w_log = b_last[..., None] - b + ic
        m_new = jnp.maximum(b_last + m, w_log.max(-1))
        wk = jnp.exp(w_log - m_new[..., None])
        decay = jnp.exp(b_last + m - m_new)
        C_new = decay[..., None, None] * C + jnp.einsum('bhj,bhjd,bhje->bhde', wk, kc, vc)
        n_new = decay[..., None] * n + jnp.einsum('bhj,bhjd->bhd', wk, kc)
        if not emit:
            return (C_new, n_new, m_new), None
        log_w = jnp.where(tri, b[..., :, None] - b[..., None, :] + ic[..., None, :], -jnp.inf)
        log_inter = b + m[..., None]
        m_row = jnp.maximum(log_w.max(-1), log_inter)
        s = jnp.einsum('bhid,bhjd->bhij', qc, kc) * jnp.exp(log_w - m_row[..., None])
        w_inter = jnp.exp(log_inter - m_row)
        num = jnp.einsum('bhij,bhje->bhie', s, vc) + w_inter[..., None] * jnp.einsum('bhid,bhde->bhie', qc, C)
        den = s.sum(-1) + w_inter * jnp.einsum('bhid,bhd->bhi', qc, n)
        den = jnp.maximum(jnp.abs(den), jnp.exp(-m_row))
        return (C_new, n_new, m_new), num / den[..., None]

    state, hs = lax.scan(step, state, tuple(chunks(a) for a in (q, k, v, i_pre, logf)))
    if not emit:
        return None, state
    return jnp.moveaxis(hs, 0, 2).reshape(bsz, nh, length, dh), state


def zero_state(bsz):
    return (jnp.zeros((bsz, N_HEADS, HEAD_DIM, HEAD_DIM), jnp.float32),
            jnp.zeros((bsz, N_HEADS, HEAD_DIM), jnp.float32),
            jnp.zeros((bsz, N_HEADS), jnp.float32))


def mlstm_bidir(p_state, states, emit):
    q, k, v, gates = _split_sizes(p_state, [D_LSTM, D_LSTM, D_LSTM, 4 * N_HEADS])

    def heads(a):
        return a.reshape(a.shape[0], a.shape[1], N_HEADS, HEAD_DIM).transpose(0, 2, 1, 3).astype(jnp.float32)

    qh = heads(q) * HEAD_DIM ** -0.5
    kh, vh = heads(k), heads(v)
    g = gates.astype(jnp.float32).transpose(0, 2, 1)
    i_f, f_f, i_b, f_b = jnp.split(g, 4, axis=1)
    h_f, st_f = mlstm_scan(qh, kh, vh, i_f, jax.nn.log_sigmoid(f_f), states[0], emit)
    rev = lambda a: jnp.flip(a, axis=2)
    h_b, st_b = mlstm_scan(rev(qh), rev(kh), rev(vh), rev(i_b), rev(jax.nn.log_sigmoid(f_b)), states[1], emit)
    if not emit:
        return None, (st_f, st_b)
    return h_f + rev(h_b), (st_f, st_b)


def mixer_output(h_lstm, p_rest, grid, w_conv, b_conv, g_head, w_pa, w_pb, w_out, b_out):
    o, z_b, b_a, c_a, x_a, z_a, g_a, g_b = _split_sizes(
        p_rest, [D_LSTM, D_LSTM, D_CONV, D_CONV, D_CONV, D_CONV, D_MODEL, D_MODEL])
    u = c_a * x_a
    if grid:
        bsz, length, ch = u.shape
        conv = dwconv3(u.reshape(bsz, length // GRID_W, GRID_W, ch), w_conv, b_conv).reshape(bsz, length, ch)
    else:
        conv = dwconv3(u, w_conv, b_conv)
    y_a = b_a * conv * jax.nn.silu(z_a)
    hn = h_lstm * lax.rsqrt(jnp.mean(h_lstm * h_lstm, axis=-1, keepdims=True) + EPS)
    bsz, _, length, _ = hn.shape
    hn = (hn.transpose(0, 2, 1, 3).reshape(bsz, length, D_LSTM) * g_head.astype(jnp.float32)).astype(p_rest.dtype)
    y_b = jax.nn.sigmoid(o) * hn * jax.nn.silu(z_b)
    merged = jax.nn.sigmoid(g_a) * (y_a @ w_pa) + jax.nn.sigmoid(g_b) * (y_b @ w_pb)
    return merged @ w_out + b_out


def setup_inputs(seed: int = 0) -> dict:
    key = jax.random.key(seed)
    ks = jax.random.split(key, 17)
    nrm = lambda k, shape, s: jax.random.normal(k, shape, jnp.float32) * s
    b_in = nrm(ks[8], (DEPTH, N_IN), 0.02)
    f_bias = jnp.linspace(F_BIAS_LO, F_BIAS_HI, N_HEADS, dtype=jnp.float32)
    og = 3 * D_LSTM
    b_in = b_in.at[:, og + N_HEADS:og + 2 * N_HEADS].add(f_bias)
    b_in = b_in.at[:, og + 3 * N_HEADS:og + 4 * N_HEADS].add(f_bias)
    return {
        "x": nrm(ks[0], (BATCH, SEQ, D_MODEL), 1.0),
        "c": nrm(ks[1], (BATCH, D_MODEL), 1.0),
        "ctx": nrm(ks[2], (BATCH, CTX_LEN, D_MODEL), 1.0),
        "c_ctx": nrm(ks[3], (D_MODEL,), 1.0),
        "w_ada": nrm(ks[4], (DEPTH, D_MODEL, 3 * D_MODEL), 0.5 * D_MODEL ** -0.5),
        "b_ada": nrm(ks[5], (DEPTH, 3 * D_MODEL), 0.02),
        "g_norm": 1.0 + nrm(ks[6], (DEPTH, D_MODEL), 0.02),
        "w_in": nrm(ks[7], (DEPTH, D_MODEL, N_IN), D_MODEL ** -0.5),
        "b_in": b_in,
        "w_conv": nrm(ks[9], (DEPTH, CONV_K, D_CONV), CONV_K ** -0.5),
        "b_conv": nrm(ks[10], (DEPTH, D_CONV), 0.02),
        "g_head": 1.0 + nrm(ks[11], (DEPTH, D_LSTM), 0.02),
        "w_pa": nrm(ks[12], (DEPTH, D_CONV, D_MODEL), D_CONV ** -0.5),
        "w_pb": nrm(ks[13], (DEPTH, D_LSTM, D_MODEL), D_LSTM ** -0.5),
        "w_out": nrm(ks[14], (DEPTH, D_MODEL, D_MODEL), D_MODEL ** -0.5),
        "b_out": nrm(ks[15], (DEPTH, D_MODEL), 0.02),
        "g_final": 1.0 + nrm(ks[16], (D_MODEL,), 0.02),
    }


def reference(x, c, ctx, c_ctx, w_ada, b_ada, g_norm, w_in, b_in, w_conv, b_conv, g_head,
              w_pa, w_pb, w_out, b_out, g_final):
    bsz = x.shape[0]
    for l in range(DEPTH):
        last = l == DEPTH - 1
        shift, scale, gate = jnp.split(jax.nn.silu(c) @ w_ada[l] + b_ada[l], 3, axis=-1)
        shift_c, scale_c, gate_c = jnp.split(jax.nn.silu(c_ctx) @ w_ada[l] + b_ada[l], 3, axis=-1)
        hx = rmsnorm(x, g_norm[l]) * (1 + scale[:, None, :]) + shift[:, None, :]
        hc = rmsnorm(ctx, g_norm[l]) * (1 + scale_c) + shift_c
        px = hx @ w_in[l] + b_in[l]
        n_ctx_cols = STATE_COLS if last else N_IN
        pc = hc @ w_in[l, :, :n_ctx_cols] + b_in[l, :n_ctx_cols]
        h_ctx, ctx_states = mlstm_bidir(pc[..., :STATE_COLS], (zero_state(bsz), zero_state(bsz)), not last)
        h_x, _ = mlstm_bidir(px[..., :STATE_COLS], ctx_states, True)
        out_x = mixer_output(h_x, px[..., STATE_COLS:], True, w_conv[l], b_conv[l], g_head[l],
                             w_pa[l], w_pb[l], w_out[l], b_out[l])
        if not last:
            out_c = mixer_output(h_ctx, pc[..., STATE_COLS:], False, w_conv[l], b_conv[l], g_head[l],
                                 w_pa[l], w_pb[l], w_out[l], b_out[l])
            ctx = ctx + gate_c * out_c
        x = x + gate[:, None, :] * out_x
    return rmsnorm(x, g_final)
```

```cpp
#include <hip/hip_runtime.h>
#include <hip/hip_cooperative_groups.h>
#include <cstdio>
#include <cstdint>
namespace cg = cooperative_groups;

#define LAS __attribute__((address_space(3)))
typedef unsigned short bf16_t;
typedef short bf16x8 __attribute__((ext_vector_type(8)));
typedef float f32x4 __attribute__((ext_vector_type(4)));
typedef unsigned u32x4 __attribute__((ext_vector_type(4)));
typedef unsigned u32x2 __attribute__((ext_vector_type(2)));

constexpr int D = 1024, NB = 8, SEQ = 2048, CTXL = 256, NH = 8, HD = 128;
constexpr int M_LAT = NB * SEQ, M_CTX = NB * CTXL, M_ALL = M_LAT + M_CTX;
constexpr int N_IN = 11296, N_PAD = 11520, N_STATE_PAD = 3328, N_REST = 8192;
constexpr int LSCAN = CTXL + SEQ;
constexpr float EPS = 1e-6f;
constexpr float QSCALE = 0.08838834764831845f;
constexpr int LDS_BYTES = 131072;

constexpr size_t MiB = 1024 * 1024;
constexpr size_t WS_MOD = 0;
constexpr size_t WS_BIAS = 128 * 1024;
constexpr size_t WS_GATES = 192 * 1024;
constexpr size_t WS_WIN = WS_GATES + (size_t)M_ALL * 32 * 4;
constexpr size_t WS_WPA = WS_WIN + (size_t)N_PAD * D * 2;
constexpr size_t WS_WPB = WS_WPA + 2 * MiB;
constexpr size_t WS_WOUT = WS_WPB + 2 * MiB;
constexpr size_t WS_A0 = WS_WOUT + 2 * MiB;
constexpr size_t WS_Q = WS_A0 + 36 * MiB;
constexpr size_t WS_K = WS_Q + 36 * MiB;
constexpr size_t WS_V = WS_K + 36 * MiB;
constexpr size_t WS_HF = WS_V + 36 * MiB;
constexpr size_t WS_HB = WS_HF + 32 * MiB;
constexpr size_t WS_END = WS_HB + 32 * MiB;

typedef __bf16 hbf16x2 __attribute__((ext_vector_type(2)));
typedef float f32x2v __attribute__((ext_vector_type(2)));
__device__ __forceinline__ unsigned cvt_pk_bf16(float lo, float hi) { const hbf16x2 r = __builtin_convertvector((f32x2v){lo, hi}, hbf16x2); return __builtin_bit_cast(unsigned, r); }
__device__ __forceinline__ float bf_lo(unsigned w) { return __uint_as_float(w << 16); }
__device__ __forceinline__ float bf_hi(unsigned w) { return __uint_as_float(w & 0xffff0000u); }
__device__ __forceinline__ float bf1(bf16_t b) { return __uint_as_float(((unsigned)b) << 16); }
__device__ __forceinline__ float fsigmoid(float x) { return __builtin_amdgcn_rcpf(1.0f + __expf(-x)); }
__device__ __forceinline__ float fsilu(float x) { return x * fsigmoid(x); }
__device__ __forceinline__ float wave_sum(float v) {
#pragma unroll
    for (int o = 1; o < 64; o <<= 1) v += __shfl_xor(v, o);
    return v;
}

namespace pg8 {
constexpr int BM = 256, BK = 64, HALF = 128, HTB = HALF * BK * 2, STAGE_BYTES = 8 * HTB, NXCD = 8, WGM = 8;
__host__ __device__ __forceinline__ int lds_byte(int r, int c) { const int st = (r >> 4) * 2 + (c >> 5), rr = r & 15, cc = c & 31, ob = rr * 64 + cc * 2; return st * 1024 + (ob ^ (((ob >> 9) & 1) << 5)); }
__host__ __device__ __forceinline__ void stage_rc(int b, int& R, int& C) { const int st = b / 1024, sb = b % 1024, swz = sb ^ (((sb >> 9) & 1) << 5); R = (st >> 1) * 16 + swz / 64; C = (st & 1) * 32 + (swz % 64) / 2; }
__host__ __device__ __forceinline__ int perm32(int rho) { const int n = rho >> 4, i = rho & 15; return 8 * (i >> 2) + 4 * n + (i & 3); }
struct Unit { int pm, pn; };
struct Gemm { const bf16_t* A; const bf16_t* Bt; int M, N, K; };
struct StaticOrder {
    int nM, nN, nwg, G, c;
    __host__ __device__ void init(int M, int N, int G_, int c_) { nM = M / BM; nN = N / BM; nwg = nM * nN; G = G_; c = c_; }
    __host__ __device__ bool map(long L, Unit& u) const {
        if (L >= nwg) return false;
        int wgid = (int)L; { const int q = nwg / NXCD, r = nwg % NXCD, xcd = wgid % NXCD, off = wgid / NXCD; wgid = (xcd < r ? xcd * (q + 1) : r * (q + 1) + (xcd - r) * q) + off; }
        const int nig = WGM * nN, gid = wgid / nig, fm = gid * WGM, gsz = (nM - fm) < WGM ? (nM - fm) : WGM;
        u.pm = fm + ((wgid % nig) % gsz); u.pn = (wgid % nig) / gsz; return true;
    }
    __host__ __device__ bool next(int i, Unit& u) const { return map((long)i * G + c, u); }
    __device__ __forceinline__ void a_ready(const Unit&) const {}
    __device__ __forceinline__ void done(const Unit&) const {}
};
struct StateOrder : StaticOrder {
    __host__ __device__ bool next(int i, Unit& u) const {
        const long L = (long)i * G + c;
        if (L < nwg) return map(L, u);
        const int idx = (int)(L - nwg); if (idx >= 72) return false;
        u.pm = 64 + (idx & 7); u.pn = 4 + (idx >> 3); return true;
    }
};

template <class Epi, class Sched>
__device__ __forceinline__ void gemm_phase(LAS unsigned char* lds, const Gemm g, const Sched& S, const Epi& E) {
    const int tid = threadIdx.x, wid = __builtin_amdgcn_readfirstlane(tid >> 6), lane = tid & 63, wr = wid >> 2, wc = wid & 3, fr = lane & 15, fq = lane >> 4;
    const int K = g.K, nt = K / BK;
    unsigned voffA[2], voffB[2];
#pragma unroll
    for (int i = 0; i < 2; ++i) { int R, C; stage_rc(tid * 16 + i * 8192, R, C); const int Rb = Epi::PERM ? ((R & ~31) + perm32(R & 31)) : R;
        voffA[i] = (unsigned)(R * K + C) * 2u; voffB[i] = (unsigned)(Rb * K + C) * 2u; }
    const size_t kstep = (size_t)(BK * 2);
    const size_t hstep = (size_t)HALF * K * 2;
    const size_t tstep = 2 * hstep;
    const unsigned ldsw = (unsigned)wid * 1024u;
    const int aoff = lds_byte(wr * 64 + fr, fq * 8), boff = lds_byte(wc * 32 + fr, fq * 8);
#define PG8_SA(b, h) (((b) * 2 + (h)) * HTB)
#define PG8_SB(b, h) ((4 + (b) * 2 + (h)) * HTB)
#define PG8_STAGE(bufoff, gbase, voff) do { _Pragma("unroll") for (int _i = 0; _i < 2; ++_i) \
        __builtin_amdgcn_global_load_lds((const unsigned*)((const char*)(gbase) + (voff)[_i]), (LAS unsigned*)(lds + (bufoff) + ldsw + _i * 8192), 16, 0, 0); } while (0)
#define PG8_LDA(dst, b, h) do { _Pragma("unroll") for (int m = 0; m < 4; ++m) _Pragma("unroll") for (int k = 0; k < 2; ++k) dst[m][k] = *(const LAS bf16x8*)(lds + PG8_SA(b, h) + aoff + m * 2048 + k * 1024); } while (0)
#define PG8_LDB(dst, b, h) do { _Pragma("unroll") for (int n = 0; n < 2; ++n) _Pragma("unroll") for (int k = 0; k < 2; ++k) dst[n][k] = *(const LAS bf16x8*)(lds + PG8_SB(b, h) + boff + n * 2048 + k * 1024); } while (0)
#define PG8_MMA(ai, bj, At, Bt) do { __builtin_amdgcn_s_setprio(1); _Pragma("unroll") for (int m = 0; m < 4; ++m) _Pragma("unroll") for (int n = 0; n < 2; ++n) _Pragma("unroll") for (int k = 0; k < 2; ++k) \
        acc[ai][bj][m][n] = __builtin_amdgcn_mfma_f32_16x16x32_bf16(Bt[n][k], At[m][k], acc[ai][bj][m][n], 0, 0, 0); __builtin_amdgcn_s_setprio(0); } while (0)
#define PG8_WAIT_V(n) asm volatile("s_waitcnt vmcnt(" #n ")" ::: "memory")
#define PG8_WAIT_L(n) asm volatile("s_waitcnt lgkmcnt(" #n ")" ::: "memory")
#define PG8_BAR __builtin_amdgcn_s_barrier()
#define PG8_SCHED __builtin_amdgcn_sched_barrier(0)
    Unit cur, nxt; int ui = 0;
    if (!S.next(0, cur)) return;
    f32x4 acc[2][2][4][2];
#pragma unroll
    for (int a = 0; a < 2; ++a)
#pragma unroll
        for (int b = 0; b < 2; ++b)
#pragma unroll
            for (int m = 0; m < 4; ++m)
#pragma unroll
                for (int n = 0; n < 2; ++n) acc[a][b][m][n] = (f32x4){0.f, 0.f, 0.f, 0.f};
    bf16x8 At[4][2], B0[2][2], B1[2][2];
    const char* cA = (const char*)g.A + (size_t)cur.pm * tstep; const char* cB = (const char*)g.Bt + (size_t)cur.pn * tstep;
    S.a_ready(cur);
    PG8_STAGE(PG8_SB(0, 0), cB, voffB); PG8_STAGE(PG8_SA(0, 0), cA, voffA); PG8_STAGE(PG8_SB(0, 1), cB + hstep, voffB); PG8_STAGE(PG8_SA(0, 1), cA + hstep, voffA);
    if (wr == 1) PG8_BAR;
    PG8_WAIT_V(4); PG8_BAR;
    PG8_STAGE(PG8_SB(1, 0), cB + kstep, voffB); PG8_STAGE(PG8_SA(1, 0), cA + kstep, voffA); PG8_STAGE(PG8_SB(1, 1), cB + hstep + kstep, voffB);
    PG8_WAIT_V(6); PG8_BAR;
    for (;;) {
        const bool has_next = S.next(ui + 1, nxt);
        const char* nA = has_next ? (const char*)g.A + (size_t)nxt.pm * tstep : cA; const char* nB = has_next ? (const char*)g.Bt + (size_t)nxt.pn * tstep : cB;
        for (int t = 0; t < nt; t += 2) {
            const bool last = (t == nt - 2);
            const char* a1 = cA + (size_t)(t + 1) * kstep;
            const char* a2 = last ? nA : cA + (size_t)(t + 2) * kstep; const char* b2 = last ? nB : cB + (size_t)(t + 2) * kstep;
            const char* a3 = a2 + kstep; const char* b3 = b2 + kstep;
            if (last && has_next) S.a_ready(nxt);
            PG8_LDB(B0, 0, 0); PG8_SCHED; PG8_LDA(At, 0, 0); PG8_STAGE(PG8_SA(1, 1), a1 + hstep, voffA);
            PG8_WAIT_L(8); PG8_BAR; PG8_WAIT_L(0); PG8_MMA(0, 0, At, B0); PG8_BAR; PG8_SCHED;
            PG8_LDB(B1, 0, 1); PG8_STAGE(PG8_SB(0, 0), b2, voffB);
            PG8_BAR; PG8_WAIT_L(0); PG8_MMA(0, 1, At, B1); PG8_BAR;
            PG8_LDA(At, 0, 1); PG8_STAGE(PG8_SA(0, 0), a2, voffA);
            PG8_BAR; PG8_WAIT_L(0); PG8_MMA(1, 0, At, B0); PG8_BAR; PG8_SCHED;
            PG8_STAGE(PG8_SB(0, 1), b2 + hstep, voffB);
            PG8_WAIT_V(6); PG8_BAR; PG8_MMA(1, 1, At, B1); PG8_BAR;
            PG8_LDB(B0, 1, 0); PG8_SCHED; PG8_LDA(At, 1, 0); PG8_STAGE(PG8_SA(0, 1), a2 + hstep, voffA);
            PG8_WAIT_L(8); PG8_BAR; PG8_WAIT_L(0); PG8_MMA(0, 0, At, B0); PG8_BAR; PG8_SCHED;
            PG8_LDB(B1, 1, 1); PG8_STAGE(PG8_SB(1, 0), b3, voffB);
            PG8_BAR; PG8_WAIT_L(0); PG8_MMA(0, 1, At, B1); PG8_BAR;
            PG8_LDA(At, 1, 1); PG8_STAGE(PG8_SA(1, 0), a3, voffA);
            PG8_BAR; PG8_WAIT_L(0); PG8_MMA(1, 0, At, B0); PG8_BAR; PG8_SCHED;
            PG8_STAGE(PG8_SB(1, 1), b3 + hstep, voffB);
            PG8_WAIT_V(6); PG8_BAR; PG8_MMA(1, 1, At, B1); PG8_BAR;
        }
        E(acc, cur, wr, wc, fr, fq); S.done(cur);
        if (!has_next) break;
#pragma unroll
        for (int a = 0; a < 2; ++a)
#pragma unroll
            for (int b = 0; b < 2; ++b)
#pragma unroll
                for (int m = 0; m < 4; ++m)
#pragma unroll
                    for (int n = 0; n < 2; ++n) acc[a][b][m][n] = (f32x4){0.f, 0.f, 0.f, 0.f};
        cur = nxt; cA = nA; cB = nB; ++ui;
    }
    PG8_WAIT_V(0);
    if (wr == 0) PG8_BAR;
    PG8_BAR;
#undef PG8_SA
#undef PG8_SB
#undef PG8_STAGE
#undef PG8_LDA
#undef PG8_LDB
#undef PG8_MMA
#undef PG8_WAIT_V
#undef PG8_WAIT_L
#undef PG8_BAR
#undef PG8_SCHED
}
}

struct EpiPtrs { unsigned char* ws; float* out; const float* x; const float* bout; };
struct EpiView {
    bf16_t *Q, *K, *V, *U, *BZ, *OZ, *SGA, *SGB, *MERGED;
    float *GATES, *TMP, *OUT;
    const float *BIAS, *X, *MOD, *BOUT;
    __device__ __forceinline__ EpiView(const EpiPtrs& e) {
        unsigned char* ws = e.ws;
        Q = (bf16_t*)(ws + WS_Q); K = (bf16_t*)(ws + WS_K); V = (bf16_t*)(ws + WS_V); U = Q; BZ = K; OZ = V;
        SGA = (bf16_t*)e.out; SGB = (bf16_t*)e.out + (size_t)M_LAT * D; MERGED = (bf16_t*)(ws + WS_A0);
        GATES = (float*)(ws + WS_GATES); TMP = (float*)(ws + WS_HF); OUT = e.out;
        BIAS = (const float*)(ws + WS_BIAS); X = e.x; MOD = (const float*)(ws + WS_MOD); BOUT = e.bout;
    }
};
__device__ __forceinline__ u32x4 pack8(const f32x4 a, const f32x4 b) { u32x4 w; w.x = cvt_pk_bf16(a[0], a[1]); w.y = cvt_pk_bf16(a[2], a[3]); w.z = cvt_pk_bf16(b[0], b[1]); w.w = cvt_pk_bf16(b[2], b[3]); return w; }
__device__ __forceinline__ void unpack8(const u32x4 w, f32x4& a, f32x4& b) { a = (f32x4){bf_lo(w.x), bf_hi(w.x), bf_lo(w.y), bf_hi(w.y)}; b = (f32x4){bf_lo(w.z), bf_hi(w.z), bf_lo(w.w), bf_hi(w.w)}; }

template <int MODE> struct Epi {
    static constexpr bool PERM = true;
    EpiPtrs PP;
    __device__ __forceinline__ void operator()(const f32x4 (&acc)[2][2][4][2], const pg8::Unit& u, int wr, int wc, int fr, int fq) const {
        const EpiView P(PP);
        const int row0 = u.pm * 256 + wr * 64 + fr;
        const int lc = wc * 32 + 8 * fq;
        if constexpr (MODE == 0) {
            const int pn = u.pn;
            if (pn < 12) {
                bf16_t* base = pn < 4 ? P.Q : (pn < 8 ? P.K : P.V);
                const float sc = pn < 4 ? QSCALE : 1.0f;
                const int cb = (pn & 3) * 256 + lc;
                f32x4 bv[2][2];
#pragma unroll
                for (int bj = 0; bj < 2; ++bj)
#pragma unroll
                    for (int n = 0; n < 2; ++n) bv[bj][n] = *(const f32x4*)(P.BIAS + pn * 256 + bj * 128 + lc + 4 * n);
#pragma unroll
                for (int ai = 0; ai < 2; ++ai)
#pragma unroll
                    for (int m = 0; m < 4; ++m) {
                        bf16_t* rowp = base + (size_t)(row0 + ai * 128 + m * 16) * D + cb;
#pragma unroll
                        for (int bj = 0; bj < 2; ++bj) {
                            const f32x4 v0 = (acc[ai][bj][m][0] + bv[bj][0]) * sc, v1 = (acc[ai][bj][m][1] + bv[bj][1]) * sc;
                            *(u32x4*)(rowp + bj * 128) = pack8(v0, v1);
                        }
                    }
            } else if (wc == 0) {
                const f32x4 b0 = *(const f32x4*)(P.BIAS + 3072 + 8 * fq), b1 = *(const f32x4*)(P.BIAS + 3072 + 8 * fq + 4);
#pragma unroll
                for (int ai = 0; ai < 2; ++ai)
#pragma unroll
                    for (int m = 0; m < 4; ++m) {
                        float* gp = P.GATES + (size_t)(row0 + ai * 128 + m * 16) * 32 + 8 * fq;
                        *(f32x4*)gp = acc[ai][0][m][0] + b0; *(f32x4*)(gp + 4) = acc[ai][0][m][1] + b1;
                    }
            }
        } else if constexpr (MODE == 1) {
            const int pn = u.pn;
            const float* bp = P.BIAS + N_STATE_PAD + pn * 256 + lc;
            f32x4 bv[2][2];
#pragma unroll
            for (int bj = 0; bj < 2; ++bj)
#pragma unroll
                for (int n = 0; n < 2; ++n) bv[bj][n] = *(const f32x4*)(bp + bj * 128 + 4 * n);
            if (pn < 24) {
                const int type = pn >> 3, k = pn & 7;
                bf16_t* base = type == 0 ? P.U : (type == 1 ? P.BZ : P.OZ);
                const int cb = k * 128 + lc;
#pragma unroll
                for (int ai = 0; ai < 2; ++ai)
#pragma unroll
                    for (int m = 0; m < 4; ++m) {
                        f32x4 r[2];
#pragma unroll
                        for (int n = 0; n < 2; ++n) {
                            const f32x4 a = acc[ai][0][m][n] + bv[0][n], c = acc[ai][1][m][n] + bv[1][n];
#pragma unroll
                            for (int x = 0; x < 4; ++x) {
                                float o;
                                if (type == 0) o = a[x] * c[x];
                                else if (type == 1) o = a[x] * fsilu(c[x]);
                                else o = c[x] * __builtin_amdgcn_rcpf((1.0f + __expf(-a[x])) * (1.0f + __expf(-c[x])));
                                r[n][x] = o;
                            }
                        }
                        *(u32x4*)(base + (size_t)(row0 + ai * 128 + m * 16) * D + cb) = pack8(r[0], r[1]);
                    }
            } else {
                bf16_t* base = pn < 28 ? P.SGA : P.SGB;
                const int cb = (pn & 3) * 256 + lc;
#pragma unroll
                for (int ai = 0; ai < 2; ++ai)
#pragma unroll
                    for (int m = 0; m < 4; ++m) {
                        bf16_t* rowp = base + (size_t)(row0 + ai * 128 + m * 16) * D + cb;
#pragma unroll
                        for (int bj = 0; bj < 2; ++bj) {
                            f32x4 r[2];
#pragma unroll
                            for (int n = 0; n < 2; ++n) { const f32x4 a = acc[ai][bj][m][n] + bv[bj][n];
#pragma unroll
                                for (int x = 0; x < 4; ++x) r[n][x] = fsigmoid(a[x]); }
                            *(u32x4*)(rowp + bj * 128) = pack8(r[0], r[1]);
                        }
                    }
            }
        } else if constexpr (MODE == 2) {
            const int cb = u.pn * 256 + lc;
#pragma unroll
            for (int ai = 0; ai < 2; ++ai)
#pragma unroll
                for (int m = 0; m < 4; ++m) {
                    const size_t ro = (size_t)(row0 + ai * 128 + m * 16) * D + cb;
#pragma unroll
                    for (int bj = 0; bj < 2; ++bj) {
                        f32x4 g0, g1; unpack8(*(const u32x4*)(P.SGA + ro + bj * 128), g0, g1);
                        *(f32x4*)(P.TMP + ro + bj * 128) = g0 * acc[ai][bj][m][0];
                        *(f32x4*)(P.TMP + ro + bj * 128 + 4) = g1 * acc[ai][bj][m][1];
                    }
                }
        } else if constexpr (MODE == 3) {
            const int cb = u.pn * 256 + lc;
#pragma unroll
            for (int ai = 0; ai < 2; ++ai)
#pragma unroll
                for (int m = 0; m < 4; ++m) {
                    const size_t ro = (size_t)(row0 + ai * 128 + m * 16) * D + cb;
#pragma unroll
                    for (int bj = 0; bj < 2; ++bj) {
                        f32x4 g0, g1; unpack8(*(const u32x4*)(P.SGB + ro + bj * 128), g0, g1);
                        const f32x4 t0 = *(const f32x4*)(P.TMP + ro + bj * 128), t1 = *(const f32x4*)(P.TMP + ro + bj * 128 + 4);
                        *(u32x4*)(P.MERGED + ro + bj * 128) = pack8(t0 + g0 * acc[ai][bj][m][0], t1 + g1 * acc[ai][bj][m][1]);
                    }
                }
        } else {
            const int cb = u.pn * 256 + lc;
            const int b = u.pm >> 3;
#pragma unroll
            for (int bj = 0; bj < 2; ++bj)
#pragma unroll
                for (int n = 0; n < 2; ++n) {
                    const f32x4 bo = *(const f32x4*)(P.BOUT + cb + bj * 128 + 4 * n), gt = *(const f32x4*)(P.MOD + b * 3072 + 2048 + cb + bj * 128 + 4 * n);
#pragma unroll
                    for (int ai = 0; ai < 2; ++ai)
#pragma unroll
                        for (int m = 0; m < 4; ++m) {
                            const size_t ro = (size_t)(row0 + ai * 128 + m * 16) * D + cb + bj * 128 + 4 * n;
                            const f32x4 xv = *(const f32x4*)(P.X + ro);
                            *(f32x4*)(P.OUT + ro) = xv + gt * (acc[ai][bj][m][n] + bo);
                        }
                }
        }
    }
};

struct Params {
    const float *x, *c, *ctx, *c_ctx, *w_ada, *b_ada, *g_norm, *w_in, *b_in, *w_conv, *b_conv, *g_head, *w_pa, *w_pb, *w_out, *b_out, *g_final;
    float* out; unsigned char* ws;
};

__device__ __forceinline__ int src_col(int n) {
    if (n < 3104) return n;
    if (n < N_STATE_PAD) return -1;
    int r = n - N_STATE_PAD;
    if (r < 6144) {
        const int type = r >> 11, u = (r >> 8) & 7, half = (r >> 7) & 1, x = r & 127;
        int base;
        if (type == 0) base = half ? 7200 : 6176;
        else if (type == 1) base = half ? 8224 : 5152;
        else base = half ? 4128 : 3104;
        return base + 128 * u + x;
    }
    return 9248 + (r - 6144);
}
__device__ __forceinline__ void transpose_item(const float* W, int N, int ncol0  , bf16_t* WT, int row_dst, int k0, LAS float* scr, int lane) {
    if (ncol0 >= 0) {
#pragma unroll 8
        for (int i = 0; i < 32; ++i) { const int kk = 2 * i + (lane >> 5); scr[kk * 33 + (lane & 31)] = W[(size_t)(k0 + kk) * N + ncol0 + (lane & 31)]; }
    } else {
#pragma unroll 8
        for (int i = 0; i < 32; ++i) { const int kk = 2 * i + (lane >> 5); scr[kk * 33 + (lane & 31)] = 0.f; }
    }
    asm volatile("s_waitcnt vmcnt(0) lgkmcnt(0)" ::: "memory");
    const int cch = lane & 7;
#pragma unroll
    for (int j = 0; j < 4; ++j) { const int n = (lane >> 3) + 8 * j; const LAS float* s = scr + (8 * cch) * 33 + n;
        u32x4 o; o.x = cvt_pk_bf16(s[0 * 33], s[1 * 33]); o.y = cvt_pk_bf16(s[2 * 33], s[3 * 33]); o.z = cvt_pk_bf16(s[4 * 33], s[5 * 33]); o.w = cvt_pk_bf16(s[6 * 33], s[7 * 33]);
        *(u32x4*)(WT + (size_t)(row_dst + n) * D + k0 + 8 * cch) = o; }
    asm volatile("s_waitcnt lgkmcnt(0)" ::: "memory");
}

__device__ __forceinline__ void phase_prep(const Params& p, LAS unsigned char* lds, int G) {
    const int tid = threadIdx.x, lane = tid & 63, wave = tid >> 6;
    unsigned char* ws = p.ws;
    for (int task = blockIdx.x; task < 96; task += G) {
        LAS float* sc = (LAS float*)lds;
        LAS float* red = (LAS float*)(lds + 9 * 1024 * 4);
        for (int i = tid; i < 9 * 1024; i += 512) { const int r = i >> 10, k = i & 1023; const float v = r < 8 ? p.c[r * 1024 + k] : p.c_ctx[k]; sc[i] = fsilu(v); }
        __syncthreads();
        const int nn = tid & 31, ks = tid >> 5, n0 = task * 32;
        float a[9];
#pragma unroll
        for (int r = 0; r < 9; ++r) a[r] = 0.f;
        for (int k = ks * 64; k < ks * 64 + 64; ++k) {
            const float w = p.w_ada[(size_t)k * 3072 + n0 + nn];
#pragma unroll
            for (int r = 0; r < 9; ++r) a[r] += sc[r * 1024 + k] * w;
        }
#pragma unroll
        for (int r = 0; r < 9; ++r) red[(ks * 9 + r) * 32 + nn] = a[r];
        __syncthreads();
        if (tid < 288) { const int r = tid >> 5; float s = p.b_ada[n0 + nn];
#pragma unroll
            for (int q = 0; q < 16; ++q) s += red[(q * 9 + r) * 32 + nn];
            ((float*)(ws + WS_MOD))[r * 3072 + n0 + nn] = s; }
        __syncthreads();
    }
    for (int i = blockIdx.x * 512 + tid; i < N_PAD; i += G * 512) { const int s = src_col(i); ((float*)(ws + WS_BIAS))[i] = s >= 0 ? p.b_in[s] : 0.f; }
    LAS float* scr = (LAS float*)(lds + wave * 8448);
    const int gw = blockIdx.x * 8 + wave, NGW = G * 8;
    constexpr int I_IN = 16 * (N_PAD / 32), I_SQ = 16 * 32;
    for (int it = gw; it < I_IN + 3 * I_SQ; it += NGW) {
        if (it < I_IN) { const int nb = it >> 4, kb = it & 15; transpose_item(p.w_in, N_IN, src_col(nb * 32), (bf16_t*)(ws + WS_WIN), nb * 32, kb * 64, scr, lane); }
        else { int r = it - I_IN; const int which = r / I_SQ; r -= which * I_SQ; const int nb = r >> 4, kb = r & 15;
            const float* W = which == 0 ? p.w_pa : (which == 1 ? p.w_pb : p.w_out);
            bf16_t* WT = (bf16_t*)(ws + (which == 0 ? WS_WPA : (which == 1 ? WS_WPB : WS_WOUT)));
            transpose_item(W, D, nb * 32, WT, nb * 32, kb * 64, scr, lane); }
    }
}

__device__ __forceinline__ void phase_hx(const Params& p, int G) {
    const int tid = threadIdx.x, lane = tid & 63, wave = tid >> 6;
    const int gw = blockIdx.x * 8 + wave, NGW = G * 8;
    const float* MOD = (const float*)(p.ws + WS_MOD);
    bf16_t* A0 = (bf16_t*)(p.ws + WS_A0);
    const int per = (M_ALL + NGW - 1) / NGW;
    int curb = -1; f32x4 gs[4], sh[4];
    for (int m = gw * per; m < (gw + 1) * per && m < M_ALL; ++m) {
        const int b = m < M_LAT ? (m >> 11) : 8;
        if (b != curb) { curb = b;
#pragma unroll
            for (int j = 0; j < 4; ++j) { const int cidx = (lane + 64 * j) * 4;
                const f32x4 g = *(const f32x4*)(p.g_norm + cidx), s = *(const f32x4*)(MOD + b * 3072 + 1024 + cidx); sh[j] = *(const f32x4*)(MOD + b * 3072 + cidx); gs[j] = g * (s + 1.0f); } }
        const float* xr = m < M_LAT ? p.x + (size_t)m * D : p.ctx + (size_t)(m - M_LAT) * D;
        f32x4 v[4]; float ss = 0.f;
#pragma unroll
        for (int j = 0; j < 4; ++j) { v[j] = *(const f32x4*)(xr + (lane + 64 * j) * 4); ss += (v[j][0] * v[j][0] + v[j][1] * v[j][1]) + (v[j][2] * v[j][2] + v[j][3] * v[j][3]); }
        const float rstd = rsqrtf(wave_sum(ss) * (1.0f / D) + EPS);
#pragma unroll
        for (int j = 0; j < 4; ++j) { const f32x4 y = v[j] * rstd * gs[j] + sh[j];
            u32x2 o; o.x = cvt_pk_bf16(y[0], y[1]); o.y = cvt_pk_bf16(y[2], y[3]);
            *(u32x2*)(A0 + (size_t)m * D + (lane + 64 * j) * 4) = o; }
    }
}

constexpr int SQ = 0, SK = 17408, SV = 34816, SKT = 44032, SVT = 62464, SC = 71680, SP = 89088, SA_ = 98304, SM_ = 107520, SB_ = 116736, SN = 125952, SQN = 126464, SRS = 126720;
constexpr int LQ = 272, LV = 144;

template <bool MAXOP> __device__ __forceinline__ float block_excl_scan256(float v, LAS float* buf, int t, float ident) {
    int cur = 0; if (t < 256) buf[t] = v; __syncthreads();
    for (int off = 1; off < 256; off <<= 1) {
        if (t < 256) { float x = buf[cur * 256 + t]; if (t >= off) { const float y = buf[cur * 256 + t - off]; x = MAXOP ? fmaxf(x, y) : x + y; } buf[(cur ^ 1) * 256 + t] = x; }
        __syncthreads(); cur ^= 1;
    }
    const float ex = (t < 256 && t > 0) ? buf[cur * 256 + t - 1] : ident;
    __syncthreads();
    return ex;
}

__device__ __forceinline__ int scan_row(int p, int b, int dir) {
    if (p < CTXL) return M_LAT + b * CTXL + (dir ? CTXL - 1 - p : p);
    const int q = p - CTXL; return b * SEQ + (dir ? SEQ - 1 - q : q);
}

__device__ __forceinline__ void phase_scan(const Params& p, LAS unsigned char* lds, int G) {
    const int tid = threadIdx.x, lane = tid & 63, wave = __builtin_amdgcn_readfirstlane(tid >> 6), fr = lane & 15, fq = lane >> 4;
    const bf16_t* Qg = (const bf16_t*)(p.ws + WS_Q); const bf16_t* Kg = (const bf16_t*)(p.ws + WS_K); const bf16_t* Vg = (const bf16_t*)(p.ws + WS_V);
    const float* GATES = (const float*)(p.ws + WS_GATES);
    LAS float* a_s = (LAS float*)(lds + SA_); LAS float* M_s = (LAS float*)(lds + SM_); LAS float* B_s = (LAS float*)(lds + SB_);
    LAS float* n_s = (LAS float*)(lds + SN); LAS float* qn_s = (LAS float*)(lds + SQN); LAS float* rs_s = (LAS float*)(lds + SRS);
    for (int item = blockIdx.x; item < 256; item += G) {
        const int dvh = item & 1, dir = (item >> 1) & 1, h = (item >> 2) & 7, b = item >> 5;
        bf16_t* Hout = (bf16_t*)(p.ws + (dir ? WS_HB : WS_HF));
        __syncthreads();
        {
            LAS float* buf = (LAS float*)(lds + SQ);
            float iv[9], lf[9]; float run = 0.f;
            if (tid < 256) {
#pragma unroll
                for (int e = 0; e < 9; ++e) { const int row = scan_row(tid * 9 + e, b, dir); const float* gp = GATES + (size_t)row * 32 + dir * 16 + h;
                    iv[e] = gp[0]; const float f = gp[8]; const float l = fminf(f, 0.f) - log1pf(__expf(-fabsf(f))); run += l; lf[e] = run; }
            }
            const float off = block_excl_scan256<false>(run, buf, tid, 0.f);
            float mx = -3.0e38f;
            if (tid < 256) {
#pragma unroll
                for (int e = 0; e < 9; ++e) { lf[e] += off; iv[e] -= lf[e]; mx = fmaxf(mx, iv[e]); }
            }
            const float moff = block_excl_scan256<true>(mx, buf, tid, 0.f);
            if (tid < 256) { float mr = fmaxf(moff, 0.f);
#pragma unroll
                for (int e = 0; e < 9; ++e) { const int pp = tid * 9 + e; mr = fmaxf(mr, iv[e]); a_s[pp] = iv[e]; M_s[pp] = mr; B_s[pp] = lf[e]; } }
            if (tid < 128) n_s[tid] = 0.f;
            for (int i = tid; i < 17408 / 16; i += 512) *(LAS u32x4*)(lds + SC + i * 16) = (u32x4){0u, 0u, 0u, 0u};
        }
        __syncthreads();
        f32x4 cacc[4];
#pragma unroll
        for (int te = 0; te < 4; ++te) cacc[te] = (f32x4){0.f, 0.f, 0.f, 0.f};
        u32x4 rq[2], rk[2], rv;
        const int colqk = h * HD + (tid & 15) * 8, colv = h * HD + dvh * 64 + (tid & 7) * 8;
#define ISSUE_LOADS(P0, EMIT) do { \
            _Pragma("unroll") for (int rep = 0; rep < 2; ++rep) { const size_t row = (size_t)scan_row((P0) + (tid >> 4) + 32 * rep, b, dir); \
                rk[rep] = *(const u32x4*)(Kg + row * D + colqk); \
                if (EMIT) rq[rep] = *(const u32x4*)(Qg + row * D + colqk); } \
            { const size_t row = (size_t)scan_row((P0) + (tid >> 3), b, dir); rv = *(const u32x4*)(Vg + row * D + colv); } } while (0)
        rq[0] = rq[1] = (u32x4){0u, 0u, 0u, 0u};
        ISSUE_LOADS(0, false);
        const int it = wave >> 1, sub = wave & 1;
        for (int ch = 0; ch < LSCAN / 64; ++ch) {
            const int p0 = ch * 64; const bool emit = p0 >= CTXL;
            __syncthreads();
#pragma unroll
            for (int rep = 0; rep < 2; ++rep) { const int r = (tid >> 4) + 32 * rep;
                *(LAS u32x4*)(lds + SK + r * LQ + (tid & 15) * 16) = rk[rep];
                if (emit) *(LAS u32x4*)(lds + SQ + r * LQ + (tid & 15) * 16) = rq[rep]; }
            *(LAS u32x4*)(lds + SV + (tid >> 3) * LV + (tid & 7) * 16) = rv;
            __syncthreads();
            if (ch + 1 < LSCAN / 64) ISSUE_LOADS(p0 + 64, (p0 + 64 >= CTXL));
            const float M_start = p0 > 0 ? M_s[p0 - 1] : 0.f, M_last = M_s[p0 + 63];
            const float decay = __expf(M_start - M_last);
            f32x4 hacc[2]; hacc[0] = (f32x4){0.f, 0.f, 0.f, 0.f}; hacc[1] = hacc[0];
            const int i_loc = it * 16 + fr;
            float M_i = 0.f, w_inter = 0.f;
            if (emit) {
                M_i = M_s[p0 + i_loc]; w_inter = __expf(M_start - M_i);
                f32x4 sacc[2]; sacc[0] = (f32x4){0.f, 0.f, 0.f, 0.f}; sacc[1] = sacc[0];
#pragma unroll
                for (int kk = 0; kk < 4; ++kk) {
                    const bf16x8 bq = *(const LAS bf16x8*)(lds + SQ + i_loc * LQ + (kk * 32 + fq * 8) * 2);
#pragma unroll
                    for (int t2 = 0; t2 < 2; ++t2) {
                        const bf16x8 ak = *(const LAS bf16x8*)(lds + SK + ((sub * 2 + t2) * 16 + fr) * LQ + (kk * 32 + fq * 8) * 2);
                        sacc[t2] = __builtin_amdgcn_mfma_f32_16x16x32_bf16(ak, bq, sacc[t2], 0, 0, 0);
                        const bf16x8 ac = *(const LAS bf16x8*)(lds + SC + ((sub * 2 + t2) * 16 + fr) * LQ + (kk * 32 + fq * 8) * 2);
                        hacc[t2] = __builtin_amdgcn_mfma_f32_16x16x32_bf16(ac, bq, hacc[t2], 0, 0, 0);
                    }
                }
                float rs = 0.f;
#pragma unroll
                for (int t2 = 0; t2 < 2; ++t2) {
                    const int j0 = (sub * 2 + t2) * 16 + 4 * fq;
                    const f32x4 av = *(const LAS f32x4*)(a_s + p0 + j0);
                    float pv[4];
#pragma unroll
                    for (int r = 0; r < 4; ++r) { const float e = (j0 + r <= i_loc) ? __expf(av[r] - M_i) : 0.f; pv[r] = sacc[t2][r] * e; rs += pv[r]; }
                    u32x2 o; o.x = cvt_pk_bf16(pv[0], pv[1]); o.y = cvt_pk_bf16(pv[2], pv[3]);
                    *(LAS u32x2*)(lds + SP + i_loc * LV + j0 * 2) = o;
                    hacc[t2] = hacc[t2] * w_inter;
                }
                rs += __shfl_xor(rs, 16); rs += __shfl_xor(rs, 32);
                if (fq == 0) rs_s[sub * 64 + i_loc] = rs;
                { const int qi = tid >> 3, part = tid & 7;
                    const u32x4 q0 = *(const LAS u32x4*)(lds + SQ + qi * LQ + part * 32), q1 = *(const LAS u32x4*)(lds + SQ + qi * LQ + part * 32 + 16);
                    const LAS float* np = n_s + part * 16;
                    float s = bf_lo(q0.x) * np[0] + bf_hi(q0.x) * np[1] + bf_lo(q0.y) * np[2] + bf_hi(q0.y) * np[3] + bf_lo(q0.z) * np[4] + bf_hi(q0.z) * np[5] + bf_lo(q0.w) * np[6] + bf_hi(q0.w) * np[7]
                            + bf_lo(q1.x) * np[8] + bf_hi(q1.x) * np[9] + bf_lo(q1.y) * np[10] + bf_hi(q1.y) * np[11] + bf_lo(q1.z) * np[12] + bf_hi(q1.z) * np[13] + bf_lo(q1.w) * np[14] + bf_hi(q1.w) * np[15];
                    s += __shfl_xor(s, 1); s += __shfl_xor(s, 2); s += __shfl_xor(s, 4);
                    if (part == 0) qn_s[qi] = s; }
            }
#pragma unroll
            for (int rep = 0; rep < 2; ++rep) { const int id = tid + 512 * rep, d = id & 127, jg = id >> 7, j0 = jg * 8;
                float kv[8];
#pragma unroll
                for (int x = 0; x < 8; ++x) kv[x] = bf1(*(const LAS bf16_t*)(lds + SK + (j0 + x) * LQ + d * 2)) * __expf(a_s[p0 + j0 + x] - M_last);
                u32x4 o; o.x = cvt_pk_bf16(kv[0], kv[1]); o.y = cvt_pk_bf16(kv[2], kv[3]); o.z = cvt_pk_bf16(kv[4], kv[5]); o.w = cvt_pk_bf16(kv[6], kv[7]);
                *(LAS u32x4*)(lds + SKT + d * LV + j0 * 2) = o; }
            { const int e = tid & 63, jg = tid >> 6, j0 = jg * 8; unsigned vv[8];
#pragma unroll
                for (int x = 0; x < 8; ++x) vv[x] = *(const LAS bf16_t*)(lds + SV + (j0 + x) * LV + e * 2);
                u32x4 o; o.x = vv[0] | (vv[1] << 16); o.y = vv[2] | (vv[3] << 16); o.z = vv[4] | (vv[5] << 16); o.w = vv[6] | (vv[7] << 16);
                *(LAS u32x4*)(lds + SVT + e * LV + j0 * 2) = o; }
            __syncthreads();
            if (emit) {
#pragma unroll
                for (int kk = 0; kk < 2; ++kk) {
                    const bf16x8 bp = *(const LAS bf16x8*)(lds + SP + i_loc * LV + (kk * 32 + fq * 8) * 2);
#pragma unroll
                    for (int t2 = 0; t2 < 2; ++t2) {
                        const bf16x8 av = *(const LAS bf16x8*)(lds + SVT + ((sub * 2 + t2) * 16 + fr) * LV + (kk * 32 + fq * 8) * 2);
                        hacc[t2] = __builtin_amdgcn_mfma_f32_16x16x32_bf16(av, bp, hacc[t2], 0, 0, 0);
                    }
                }
                float den = rs_s[i_loc] + rs_s[64 + i_loc] + w_inter * qn_s[i_loc];
                den = fmaxf(fabsf(den), __expf(-(B_s[p0 + i_loc] + M_i)));
                const float rden = __builtin_amdgcn_rcpf(den);
                const size_t orow = (size_t)scan_row(p0 + i_loc, b, dir);
#pragma unroll
                for (int t2 = 0; t2 < 2; ++t2) { const int e0 = (sub * 2 + t2) * 16 + 4 * fq;
                    u32x2 o; o.x = cvt_pk_bf16(hacc[t2][0] * rden, hacc[t2][1] * rden); o.y = cvt_pk_bf16(hacc[t2][2] * rden, hacc[t2][3] * rden);
                    *(u32x2*)(Hout + orow * D + h * HD + dvh * 64 + e0) = o; }
            }
#pragma unroll
            for (int te = 0; te < 4; ++te) cacc[te] = cacc[te] * decay;
#pragma unroll
            for (int kk = 0; kk < 2; ++kk) {
                const bf16x8 ak = *(const LAS bf16x8*)(lds + SKT + (wave * 16 + fr) * LV + (kk * 32 + fq * 8) * 2);
#pragma unroll
                for (int te = 0; te < 4; ++te) {
                    const bf16x8 bv = *(const LAS bf16x8*)(lds + SVT + (te * 16 + fr) * LV + (kk * 32 + fq * 8) * 2);
                    cacc[te] = __builtin_amdgcn_mfma_f32_16x16x32_bf16(ak, bv, cacc[te], 0, 0, 0);
                }
            }
#pragma unroll
            for (int te = 0; te < 4; ++te) { u32x2 o; o.x = cvt_pk_bf16(cacc[te][0], cacc[te][1]); o.y = cvt_pk_bf16(cacc[te][2], cacc[te][3]);
                *(LAS u32x2*)(lds + SC + (te * 16 + fr) * LQ + (wave * 16 + 4 * fq) * 2) = o; }
            if (tid < 128) { float s = 0.f;
#pragma unroll
                for (int g8 = 0; g8 < 8; ++g8) { const u32x4 w = *(const LAS u32x4*)(lds + SKT + tid * LV + g8 * 16);
                    s += (bf_lo(w.x) + bf_hi(w.x)) + (bf_lo(w.y) + bf_hi(w.y)) + (bf_lo(w.z) + bf_hi(w.z)) + (bf_lo(w.w) + bf_hi(w.w)); }
                n_s[tid] = decay * n_s[tid] + s; }
        }
    }
    __syncthreads();
}

__device__ __forceinline__ void phase_mix(const Params& p, int G) {
    const int tid = threadIdx.x, lane = tid & 63, wave = tid >> 6;
    const int gw = blockIdx.x * 8 + wave, NGW = G * 8;
    const bf16_t* U = (const bf16_t*)(p.ws + WS_Q); bf16_t* BZ = (bf16_t*)(p.ws + WS_K); bf16_t* OZ = (bf16_t*)(p.ws + WS_V);
    const bf16_t* HF = (const bf16_t*)(p.ws + WS_HF); const bf16_t* HB = (const bf16_t*)(p.ws + WS_HB);
    const int c0 = lane * 16;
    f32x4 w0[4], w1[4], w2[4], bc[4], gh[4];
#pragma unroll
    for (int j = 0; j < 4; ++j) { w0[j] = *(const f32x4*)(p.w_conv + c0 + 4 * j); w1[j] = *(const f32x4*)(p.w_conv + D + c0 + 4 * j); w2[j] = *(const f32x4*)(p.w_conv + 2 * D + c0 + 4 * j);
        bc[j] = *(const f32x4*)(p.b_conv + c0 + 4 * j); gh[j] = *(const f32x4*)(p.g_head + c0 + 4 * j); }
    const int per = (M_LAT + NGW - 1) / NGW;
    for (int m = gw * per; m < (gw + 1) * per && m < M_LAT; ++m) {
        const int t = m & (SEQ - 1);
        const size_t ro = (size_t)m * D + c0;
        f32x4 uc[4], um[4], up[4], bz[4];
        { f32x4 a, b2; unpack8(*(const u32x4*)(U + ro), a, b2); uc[0] = a; uc[1] = b2; unpack8(*(const u32x4*)(U + ro + 8), a, b2); uc[2] = a; uc[3] = b2; }
        if ((t & 63) != 0) { f32x4 a, b2; unpack8(*(const u32x4*)(U + ro - D), a, b2); um[0] = a; um[1] = b2; unpack8(*(const u32x4*)(U + ro - D + 8), a, b2); um[2] = a; um[3] = b2; }
        else { um[0] = um[1] = um[2] = um[3] = (f32x4){0.f, 0.f, 0.f, 0.f}; }
        if ((t & 63) != 63) { f32x4 a, b2; unpack8(*(const u32x4*)(U + ro + D), a, b2); up[0] = a; up[1] = b2; unpack8(*(const u32x4*)(U + ro + D + 8), a, b2); up[2] = a; up[3] = b2; }
        else { up[0] = up[1] = up[2] = up[3] = (f32x4){0.f, 0.f, 0.f, 0.f}; }
        { f32x4 a, b2; unpack8(*(const u32x4*)(BZ + ro), a, b2); bz[0] = a; bz[1] = b2; unpack8(*(const u32x4*)(BZ + ro + 8), a, b2); bz[2] = a; bz[3] = b2; }
        f32x4 ya[4];
#pragma unroll
        for (int j = 0; j < 4; ++j) ya[j] = bz[j] * (w0[j] * um[j] + w1[j] * uc[j] + w2[j] * up[j] + bc[j]);
        *(u32x4*)(BZ + ro) = pack8(ya[0], ya[1]); *(u32x4*)(BZ + ro + 8) = pack8(ya[2], ya[3]);
        f32x4 hv[4], oz[4];
        { f32x4 a, b2, c2, d2; unpack8(*(const u32x4*)(HF + ro), a, b2); unpack8(*(const u32x4*)(HB + ro), c2, d2); hv[0] = a + c2; hv[1] = b2 + d2;
          unpack8(*(const u32x4*)(HF + ro + 8), a, b2); unpack8(*(const u32x4*)(HB + ro + 8), c2, d2); hv[2] = a + c2; hv[3] = b2 + d2; }
        { f32x4 a, b2; unpack8(*(const u32x4*)(OZ + ro), a, b2); oz[0] = a; oz[1] = b2; unpack8(*(const u32x4*)(OZ + ro + 8), a, b2); oz[2] = a; oz[3] = b2; }
        float ss = 0.f;
#pragma unroll
        for (int j = 0; j < 4; ++j) ss += (hv[j][0] * hv[j][0] + hv[j][1] * hv[j][1]) + (hv[j][2] * hv[j][2] + hv[j][3] * hv[j][3]);
        ss += __shfl_xor(ss, 1); ss += __shfl_xor(ss, 2); ss += __shfl_xor(ss, 4);
        const float rstd = rsqrtf(ss * (1.0f / HD) + EPS);
        f32x4 yb[4];
#pragma unroll
        for (int j = 0; j < 4; ++j) yb[j] = oz[j] * (hv[j] * rstd * gh[j]);
        *(u32x4*)(OZ + ro) = pack8(yb[0], yb[1]); *(u32x4*)(OZ + ro + 8) = pack8(yb[2], yb[3]);
    }
}

__device__ __forceinline__ void phase_final(const Params& p, int G) {
    const int tid = threadIdx.x, lane = tid & 63, wave = tid >> 6;
    const int gw = blockIdx.x * 8 + wave, NGW = G * 8;
    f32x4 gf[4];
#pragma unroll
    for (int j = 0; j < 4; ++j) gf[j] = *(const f32x4*)(p.g_final + (lane + 64 * j) * 4);
    const int per = (M_LAT + NGW - 1) / NGW;
    for (int m = gw * per; m < (gw + 1) * per && m < M_LAT; ++m) {
        float* xr = p.out + (size_t)m * D;
        f32x4 v[4]; float ss = 0.f;
#pragma unroll
        for (int j = 0; j < 4; ++j) { v[j] = *(const f32x4*)(xr + (lane + 64 * j) * 4); ss += (v[j][0] * v[j][0] + v[j][1] * v[j][1]) + (v[j][2] * v[j][2] + v[j][3] * v[j][3]); }
        const float rstd = rsqrtf(wave_sum(ss) * (1.0f / D) + EPS);
#pragma unroll
        for (int j = 0; j < 4; ++j) *(f32x4*)(xr + (lane + 64 * j) * 4) = v[j] * rstd * gf[j];
    }
}

#ifndef STOP_AFTER
#define STOP_AFTER 99
#endif
__device__ __forceinline__ void dbg_dump2(float* out, const bf16_t* a, const bf16_t* b, int G) {
    for (size_t i = (size_t)blockIdx.x * 512 + threadIdx.x; i < (size_t)M_LAT * D / 8; i += (size_t)G * 512) {
        f32x4 a0, a1, b0, b1; unpack8(*(const u32x4*)(a + i * 8), a0, a1); unpack8(*(const u32x4*)(b + i * 8), b0, b1);
        *(f32x4*)(out + i * 8) = a0 + b0; *(f32x4*)(out + i * 8 + 4) = a1 + b1; }
}
__global__ void __launch_bounds__(512, 2) fwd_megakernel(Params p) {
    extern __shared__ __attribute__((aligned(16))) unsigned char shm[];
    LAS unsigned char* lds = (LAS unsigned char*)shm;
    cg::grid_group grid = cg::this_grid();
#define GRID_SYNC() do { asm volatile("s_waitcnt vmcnt(0) lgkmcnt(0)" ::: "memory"); grid.sync(); \
        __builtin_amdgcn_fence(__ATOMIC_ACQUIRE, "agent"); asm volatile("s_waitcnt vmcnt(0)" ::: "memory"); } while (0)
    const int G = gridDim.x;
    unsigned char* ws = p.ws;
    EpiPtrs E; E.ws = ws; E.out = p.out; E.x = p.x; E.bout = p.b_out;

    phase_prep(p, lds, G);
    GRID_SYNC();
    phase_hx(p, G);
    GRID_SYNC();
    {
        pg8::Gemm g{(const bf16_t*)(ws + WS_A0), (const bf16_t*)(ws + WS_WIN), M_ALL, N_STATE_PAD, D};
        pg8::StateOrder S; S.init(M_LAT, N_STATE_PAD, G, (int)blockIdx.x);
        Epi<0> e{E};
        pg8::gemm_phase(lds, g, S, e);
    }
    GRID_SYNC();
    if (STOP_AFTER == 2) { dbg_dump2(p.out, (const bf16_t*)(ws + WS_K), (const bf16_t*)(ws + WS_V), G); return; }
    if (STOP_AFTER == 21) {
        for (size_t i = (size_t)blockIdx.x * 512 + threadIdx.x; i < (size_t)M_LAT * D; i += (size_t)G * 512) { const size_t m = i >> 10, c = i & 1023; const size_t mc = M_LAT + (m & 2047);
            p.out[i] = bf1(((const bf16_t*)(ws + WS_Q))[i]) + bf1(((const bf16_t*)(ws + WS_K))[mc * D + c]) + bf1(((const bf16_t*)(ws + WS_V))[mc * D + c]) + ((const float*)(ws + WS_GATES))[((m * 7 + (c >> 5)) % M_ALL) * 32 + (c & 31)]; }
        return; }
    phase_scan(p, lds, G);
    GRID_SYNC();
    if (STOP_AFTER == 3) { dbg_dump2(p.out, (const bf16_t*)(ws + WS_HF), (const bf16_t*)(ws + WS_HB), G); return; }
    {
        pg8::Gemm g{(const bf16_t*)(ws + WS_A0), (const bf16_t*)(ws + WS_WIN) + (size_t)N_STATE_PAD * D, M_LAT, N_REST, D};
        pg8::StaticOrder S; S.init(M_LAT, N_REST, G, (int)blockIdx.x);
        Epi<1> e{E};
        pg8::gemm_phase(lds, g, S, e);
    }
    GRID_SYNC();
    phase_mix(p, G);
    GRID_SYNC();
    if (STOP_AFTER == 4) { dbg_dump2((float*)(ws + WS_HF), (const bf16_t*)(ws + WS_K), (const bf16_t*)(ws + WS_V), G); GRID_SYNC();
        for (size_t i = (size_t)blockIdx.x * 512 + threadIdx.x; i < (size_t)M_LAT * D / 4; i += (size_t)G * 512) ((f32x4*)p.out)[i] = ((const f32x4*)(ws + WS_HF))[i]; return; }
    {
        pg8::StaticOrder S; S.init(M_LAT, D, G, (int)blockIdx.x);
        { pg8::Gemm g{(const bf16_t*)(ws + WS_K), (const bf16_t*)(ws + WS_WPA), M_LAT, D, D}; Epi<2> e{E}; pg8::gemm_phase(lds, g, S, e); }
        { pg8::Gemm g{(const bf16_t*)(ws + WS_V), (const bf16_t*)(ws + WS_WPB), M_LAT, D, D}; Epi<3> e{E}; pg8::gemm_phase(lds, g, S, e); }
    }
    GRID_SYNC();
    {
        pg8::StaticOrder S; S.init(M_LAT, D, G, (int)blockIdx.x);
        pg8::Gemm g{(const bf16_t*)(ws + WS_A0), (const bf16_t*)(ws + WS_WOUT), M_LAT, D, D}; Epi<4> e{E}; pg8::gemm_phase(lds, g, S, e);
    }
    GRID_SYNC();
    phase_final(p, G);
}

extern "C" void kernel_launch(void* const* d_in, const int* in_sizes, int n_in, void* d_out, int out_size, void* d_ws, size_t ws_size, hipStream_t stream) {
    static int grid_blocks = 0;
    if (!grid_blocks) {
        int dev = 0, cus = 0, per_cu = 0;
        hipGetDevice(&dev);
        hipDeviceGetAttribute(&cus, hipDeviceAttributeMultiprocessorCount, dev);
        if (hipFuncSetAttribute((const void*)fwd_megakernel, hipFuncAttributeMaxDynamicSharedMemorySize, LDS_BYTES) != hipSuccess) fprintf(stderr, "kernel_launch: hipFuncSetAttribute failed\n");
        if (hipOccupancyMaxActiveBlocksPerMultiprocessor(&per_cu, (const void*)fwd_megakernel, 512, LDS_BYTES) != hipSuccess || per_cu < 1) { fprintf(stderr, "kernel_launch: occupancy query gave %d\n", per_cu); per_cu = 1; }
        grid_blocks = cus * per_cu;
        if (grid_blocks > 256) grid_blocks = 256;
        if (ws_size < WS_END) fprintf(stderr, "kernel_launch: workspace too small: %zu < %zu\n", ws_size, (size_t)WS_END);
    }
    Params p{};
    p.x = (const float*)d_in[0]; p.c = (const float*)d_in[1]; p.ctx = (const float*)d_in[2]; p.c_ctx = (const float*)d_in[3];
    p.w_ada = (const float*)d_in[4]; p.b_ada = (const float*)d_in[5]; p.g_norm = (const float*)d_in[6]; p.w_in = (const float*)d_in[7]; p.b_in = (const float*)d_in[8];
    p.w_conv = (const float*)d_in[9]; p.b_conv = (const float*)d_in[10]; p.g_head = (const float*)d_in[11]; p.w_pa = (const float*)d_in[12]; p.w_pb = (const float*)d_in[13];
    p.w_out = (const float*)d_in[14]; p.b_out = (const float*)d_in[15]; p.g_final = (const float*)d_in[16];
    p.out = (float*)d_out; p.ws = (unsigned char*)d_ws;
    void* args[] = {&p};
    hipError_t e = hipLaunchCooperativeKernel((const void*)fwd_megakernel, dim3(grid_blocks), dim3(512), args, LDS_BYTES, stream);
    if (e != hipSuccess) fprintf(stderr, "cooperative launch failed: %s (grid %d)\n", hipGetErrorString(e), grid_blocks);
}
```

```cpp
#include <hip/hip_runtime.h>
#include <hip/hip_cooperative_groups.h>
#include <cstdio>
#include <cstdint>
namespace cg = cooperative_groups;

#define LAS __attribute__((address_space(3)))
typedef unsigned short bf16_t;
typedef short bf16x8 __attribute__((ext_vector_type(8)));
typedef float f32x4 __attribute__((ext_vector_type(4)));
typedef unsigned u32x4 __attribute__((ext_vector_type(4)));
typedef unsigned u32x2 __attribute__((ext_vector_type(2)));

constexpr int D = 1024, NB = 8, SEQ = 2048, CTXL = 256, NH = 8, HD = 128;
constexpr int M_LAT = NB * SEQ, M_CTX = NB * CTXL, M_ALL = M_LAT + M_CTX;
constexpr int N_IN = 11296, N_PAD = 11520, N_STATE_PAD = 3328, N_REST = 8192;
constexpr int LSCAN = CTXL + SEQ;
constexpr float EPS = 1e-6f;
constexpr float QSCALE = 0.08838834764831845f;
constexpr int LDS_STAGE = 131072, LDS_BYTES = LDS_STAGE + 64;

constexpr size_t MiB = 1024 * 1024;
constexpr size_t WS_MOD = 0;
constexpr size_t WS_BIAS = 128 * 1024;
constexpr size_t WS_BAR = 176 * 1024;
constexpr size_t WS_GATES = 192 * 1024;
constexpr size_t WS_WIN = WS_GATES + (size_t)M_ALL * 32 * 4;
constexpr size_t WS_WPA = WS_WIN + (size_t)N_PAD * D * 2;
constexpr size_t WS_WPB = WS_WPA + 2 * MiB;
constexpr size_t WS_WOUT = WS_WPB + 2 * MiB;
constexpr size_t WS_A0 = WS_WOUT + 2 * MiB;
constexpr size_t WS_Q = WS_A0 + 36 * MiB;
constexpr size_t WS_K = WS_Q + 36 * MiB;
constexpr size_t WS_V = WS_K + 36 * MiB;
constexpr size_t WS_HF = WS_V + 36 * MiB;
constexpr size_t WS_HB = WS_HF + 32 * MiB;
constexpr size_t WS_END = WS_HB + 32 * MiB;

typedef __bf16 hbf16x2 __attribute__((ext_vector_type(2)));
typedef float f32x2v __attribute__((ext_vector_type(2)));
__device__ __forceinline__ unsigned cvt_pk_bf16(float lo, float hi) { const hbf16x2 r = __builtin_convertvector((f32x2v){lo, hi}, hbf16x2); return __builtin_bit_cast(unsigned, r); }
__device__ __forceinline__ float bf_lo(unsigned w) { return __uint_as_float(w << 16); }
__device__ __forceinline__ float bf_hi(unsigned w) { return __uint_as_float(w & 0xffff0000u); }
__device__ __forceinline__ float bf1(bf16_t b) { return __uint_as_float(((unsigned)b) << 16); }
__device__ __forceinline__ float fsigmoid(float x) { return __builtin_amdgcn_rcpf(1.0f + __expf(-x)); }
__device__ __forceinline__ float fsilu(float x) { return x * fsigmoid(x); }
__device__ __forceinline__ float wave_sum(float v) {
#pragma unroll
    for (int o = 1; o < 64; o <<= 1) v += __shfl_xor(v, o);
    return v;
}

namespace pg8 {
constexpr int BM = 256, BK = 64, HALF = 128, HTB = HALF * BK * 2, STAGE_BYTES = 8 * HTB, NXCD = 8, WGM = 8;
__host__ __device__ __forceinline__ int lds_byte(int r, int c) { const int st = (r >> 4) * 2 + (c >> 5), rr = r & 15, cc = c & 31, ob = rr * 64 + cc * 2; return st * 1024 + (ob ^ (((ob >> 9) & 1) << 5)); }
__host__ __device__ __forceinline__ void stage_rc(int b, int& R, int& C) { const int st = b / 1024, sb = b % 1024, swz = sb ^ (((sb >> 9) & 1) << 5); R = (st >> 1) * 16 + swz / 64; C = (st & 1) * 32 + (swz % 64) / 2; }
__host__ __device__ __forceinline__ int perm32(int rho) { const int n = rho >> 4, i = rho & 15; return 8 * (i >> 2) + 4 * n + (i & 3); }
struct Unit { int pm, pn; };
struct Gemm { const bf16_t* A; const bf16_t* Bt; int M, N, K; };
struct StaticOrder {
    int nM, nN, nwg, G, c;
    __host__ __device__ void init(int M, int N, int G_, int c_) { nM = M / BM; nN = N / BM; nwg = nM * nN; G = G_; c = c_; }
    __host__ __device__ bool map(long L, Unit& u) const {
        if (L >= nwg) return false;
        int wgid = (int)L; { const int q = nwg / NXCD, r = nwg % NXCD, xcd = wgid % NXCD, off = wgid / NXCD; wgid = (xcd < r ? xcd * (q + 1) : r * (q + 1) + (xcd - r) * q) + off; }
        const int nig = WGM * nN, gid = wgid / nig, fm = gid * WGM, gsz = (nM - fm) < WGM ? (nM - fm) : WGM;
        u.pm = fm + ((wgid % nig) % gsz); u.pn = (wgid % nig) / gsz; return true;
    }
    __host__ __device__ bool next(int i, Unit& u) const { return map((long)i * G + c, u); }
    __device__ __forceinline__ void a_ready(const Unit&) const {}
    __device__ __forceinline__ void done(const Unit&) const {}
};
struct StateOrder : StaticOrder {
    __host__ __device__ bool next(int i, Unit& u) const {
        const long L = (long)i * G + c;
        if (L < nwg) return map(L, u);
        const int idx = (int)(L - nwg); if (idx >= 72) return false;
        u.pm = 64 + (idx & 7); u.pn = 4 + (idx >> 3); return true;
    }
};

struct PairOrder : StaticOrder {
    __host__ __device__ bool next(int i, Unit& u) const {
        if (!map((long)(i >> 1) * G + c, u)) return false;
        if (i & 1) { u.pm += 72; u.pn += 4; }
        return true;
    }
};

template <class Epi, class Sched>
__device__ __forceinline__ void gemm_phase(LAS unsigned char* lds, const Gemm g, const Sched& S, const Epi& E) {
    int tid = threadIdx.x; asm volatile("" : "+v"(tid));
    const int wid = __builtin_amdgcn_readfirstlane(tid >> 6), lane = tid & 63, wr = wid >> 2, wc = wid & 3, fr = lane & 15, fq = lane >> 4;
    const int K = g.K, nt = K / BK;
    unsigned voffA[2], voffB[2];
#pragma unroll
    for (int i = 0; i < 2; ++i) { int R, C; stage_rc(tid * 16 + i * 8192, R, C); const int Rb = Epi::PERM ? ((R & ~31) + perm32(R & 31)) : R;
        voffA[i] = (unsigned)(R * K + C) * 2u; voffB[i] = (unsigned)(Rb * K + C) * 2u; }
    const size_t kstep = (size_t)(BK * 2);
    const size_t hstep = (size_t)HALF * K * 2;
    const size_t tstep = 2 * hstep;
    const unsigned ldsw = (unsigned)wid * 1024u;
    const int aoff = lds_byte(wr * 64 + fr, fq * 8), boff = lds_byte(wc * 32 + fr, fq * 8);
#define PG8_SA(b, h) (((b) * 2 + (h)) * HTB)
#define PG8_SB(b, h) ((4 + (b) * 2 + (h)) * HTB)
#define PG8_STAGE(bufoff, gbase, voff) do { _Pragma("unroll") for (int _i = 0; _i < 2; ++_i) \
        __builtin_amdgcn_global_load_lds((const unsigned*)((const char*)(gbase) + (voff)[_i]), (LAS unsigned*)(lds + (bufoff) + ldsw + _i * 8192), 16, 0, 0); } while (0)
#define PG8_LDA(dst, b, h) do { _Pragma("unroll") for (int m = 0; m < 4; ++m) _Pragma("unroll") for (int k = 0; k < 2; ++k) dst[m][k] = *(const LAS bf16x8*)(lds + PG8_SA(b, h) + aoff + m * 2048 + k * 1024); } while (0)
#define PG8_LDB(dst, b, h) do { _Pragma("unroll") for (int n = 0; n < 2; ++n) _Pragma("unroll") for (int k = 0; k < 2; ++k) dst[n][k] = *(const LAS bf16x8*)(lds + PG8_SB(b, h) + boff + n * 2048 + k * 1024); } while (0)
#define PG8_MMA(ai, bj, At, Bt) do { __builtin_amdgcn_s_setprio(1); _Pragma("unroll") for (int m = 0; m < 4; ++m) _Pragma("unroll") for (int n = 0; n < 2; ++n) _Pragma("unroll") for (int k = 0; k < 2; ++k) \
        acc[ai][bj][m][n] = __builtin_amdgcn_mfma_f32_16x16x32_bf16(Bt[n][k], At[m][k], acc[ai][bj][m][n], 0, 0, 0); __builtin_amdgcn_s_setprio(0); } while (0)
#define PG8_WAIT_V(n) asm volatile("s_waitcnt vmcnt(" #n ")" ::: "memory")
#define PG8_WAIT_L(n) asm volatile("s_waitcnt lgkmcnt(" #n ")" ::: "memory")
#define PG8_BAR __builtin_amdgcn_s_barrier()
#define PG8_SCHED __builtin_amdgcn_sched_barrier(0)
    Unit cur, nxt; int ui = 0;
    if (!S.next(0, cur)) return;
    f32x4 acc[2][2][4][2];
#pragma unroll
    for (int a = 0; a < 2; ++a)
#pragma unroll
        for (int b = 0; b < 2; ++b)
#pragma unroll
            for (int m = 0; m < 4; ++m)
#pragma unroll
                for (int n = 0; n < 2; ++n) acc[a][b][m][n] = (f32x4){0.f, 0.f, 0.f, 0.f};
    bf16x8 At[4][2], B0[2][2], B1[2][2];
    const char* cA = (const char*)g.A + (size_t)cur.pm * tstep; const char* cB = (const char*)g.Bt + (size_t)cur.pn * tstep;
    S.a_ready(cur);
    PG8_STAGE(PG8_SB(0, 0), cB, voffB); PG8_STAGE(PG8_SA(0, 0), cA, voffA); PG8_STAGE(PG8_SB(0, 1), cB + hstep, voffB); PG8_STAGE(PG8_SA(0, 1), cA + hstep, voffA);
    if (wr == 1) PG8_BAR;
    PG8_WAIT_V(4); PG8_BAR;
    PG8_STAGE(PG8_SB(1, 0), cB + kstep, voffB); PG8_STAGE(PG8_SA(1, 0), cA + kstep, voffA); PG8_STAGE(PG8_SB(1, 1), cB + hstep + kstep, voffB);
    PG8_WAIT_V(6); PG8_BAR;
    for (;;) {
        const bool has_next = S.next(ui + 1, nxt);
        const char* nA = has_next ? (const char*)g.A + (size_t)nxt.pm * tstep : cA; const char* nB = has_next ? (const char*)g.Bt + (size_t)nxt.pn * tstep : cB;
        for (int t = 0; t < nt; t += 2) {
            const bool last = (t == nt - 2);
            const char* a1 = cA + (size_t)(t + 1) * kstep;
            const char* a2 = last ? nA : cA + (size_t)(t + 2) * kstep; const char* b2 = last ? nB : cB + (size_t)(t + 2) * kstep;
            const char* a3 = a2 + kstep; const char* b3 = b2 + kstep;
            if (last && has_next) S.a_ready(nxt);
            PG8_LDB(B0, 0, 0); PG8_SCHED; PG8_LDA(At, 0, 0); PG8_STAGE(PG8_SA(1, 1), a1 + hstep, voffA);
            PG8_WAIT_L(8); PG8_BAR; PG8_WAIT_L(0); PG8_MMA(0, 0, At, B0); PG8_BAR; PG8_SCHED;
            PG8_LDB(B1, 0, 1); PG8_STAGE(PG8_SB(0, 0), b2, voffB);
            PG8_BAR; PG8_WAIT_L(0); PG8_MMA(0, 1, At, B1); PG8_BAR;
            PG8_LDA(At, 0, 1); PG8_STAGE(PG8_SA(0, 0), a2, voffA);
            PG8_BAR; PG8_WAIT_L(0); PG8_MMA(1, 0, At, B0); PG8_BAR; PG8_SCHED;
            PG8_STAGE(PG8_SB(0, 1), b2 + hstep, voffB);
            PG8_WAIT_V(6); PG8_BAR; PG8_MMA(1, 1, At, B1); PG8_BAR;
            PG8_LDB(B0, 1, 0); PG8_SCHED; PG8_LDA(At, 1, 0); PG8_STAGE(PG8_SA(0, 1), a2 + hstep, voffA);
            PG8_WAIT_L(8); PG8_BAR; PG8_WAIT_L(0); PG8_MMA(0, 0, At, B0); PG8_BAR; PG8_SCHED;
            PG8_LDB(B1, 1, 1); PG8_STAGE(PG8_SB(1, 0), b3, voffB);
            PG8_BAR; PG8_WAIT_L(0); PG8_MMA(0, 1, At, B1); PG8_BAR;
            PG8_LDA(At, 1, 1); PG8_STAGE(PG8_SA(1, 0), a3, voffA);
            PG8_BAR; PG8_WAIT_L(0); PG8_MMA(1, 0, At, B0); PG8_BAR; PG8_SCHED;
            PG8_STAGE(PG8_SB(1, 1), b3 + hstep, voffB);
            PG8_WAIT_V(6); PG8_BAR; PG8_MMA(1, 1, At, B1); PG8_BAR;
        }
        E(acc, cur, wr, wc, fr, fq); S.done(cur);
        if (!has_next) break;
        if (!E.keep(cur)) {
#pragma unroll
            for (int a = 0; a < 2; ++a)
#pragma unroll
                for (int b = 0; b < 2; ++b)
#pragma unroll
                    for (int m = 0; m < 4; ++m)
#pragma unroll
                        for (int n = 0; n < 2; ++n) acc[a][b][m][n] = (f32x4){0.f, 0.f, 0.f, 0.f};
        }
        cur = nxt; cA = nA; cB = nB; ++ui;
    }
    PG8_WAIT_V(0);
    if (wr == 0) PG8_BAR;
    PG8_BAR;
#undef PG8_SA
#undef PG8_SB
#undef PG8_STAGE
#undef PG8_LDA
#undef PG8_LDB
#undef PG8_MMA
#undef PG8_WAIT_V
#undef PG8_WAIT_L
#undef PG8_BAR
#undef PG8_SCHED
}
}

struct EpiPtrs { unsigned char* ws; float* out; const float* x; const float* bout; };
struct EpiView {
    bf16_t *Q, *K, *V, *U, *BZ, *OZ, *SGA, *SGB, *MERGED;
    float *GATES, *TMP, *OUT;
    const float *BIAS, *X, *MOD, *BOUT;
    __device__ __forceinline__ EpiView(const EpiPtrs& e) {
        unsigned char* ws = e.ws;
        Q = (bf16_t*)(ws + WS_Q); K = (bf16_t*)(ws + WS_K); V = (bf16_t*)(ws + WS_V); U = Q; BZ = K; OZ = V;
        SGA = (bf16_t*)e.out; SGB = (bf16_t*)e.out + (size_t)M_LAT * D; MERGED = (bf16_t*)(ws + WS_A0);
        GATES = (float*)(ws + WS_GATES); TMP = (float*)(ws + WS_HF); OUT = e.out;
        BIAS = (const float*)(ws + WS_BIAS); X = e.x; MOD = (const float*)(ws + WS_MOD); BOUT = e.bout;
    }
};
__device__ __forceinline__ u32x4 pack8(const f32x4 a, const f32x4 b) { u32x4 w; w.x = cvt_pk_bf16(a[0], a[1]); w.y = cvt_pk_bf16(a[2], a[3]); w.z = cvt_pk_bf16(b[0], b[1]); w.w = cvt_pk_bf16(b[2], b[3]); return w; }
__device__ __forceinline__ void unpack8(const u32x4 w, f32x4& a, f32x4& b) { a = (f32x4){bf_lo(w.x), bf_hi(w.x), bf_lo(w.y), bf_hi(w.y)}; b = (f32x4){bf_lo(w.z), bf_hi(w.z), bf_lo(w.w), bf_hi(w.w)}; }

template <int MODE> struct Epi {
    static constexpr bool PERM = true;
    EpiPtrs PP;
    __device__ __forceinline__ bool keep(const pg8::Unit& u) const { return MODE == 2 && u.pm < 72; }
    __device__ __forceinline__ void operator()(f32x4 (&acc)[2][2][4][2], const pg8::Unit& u, int wr, int wc, int fr, int fq) const {
        const EpiView P(PP);
        const int row0 = u.pm * 256 + wr * 64 + fr;
        const int lc = wc * 32 + 8 * fq;
        if constexpr (MODE == 0) {
            const int pn = u.pn;
            if (pn < 12) {
                bf16_t* base = pn < 4 ? P.Q : (pn < 8 ? P.K : P.V);
                const float sc = pn < 4 ? QSCALE : 1.0f;
                const int cb = (pn & 3) * 256 + lc;
#pragma unroll
                for (int bj = 0; bj < 2; ++bj) {
                    const f32x4 bv0 = *(const f32x4*)(P.BIAS + pn * 256 + bj * 128 + lc), bv1 = *(const f32x4*)(P.BIAS + pn * 256 + bj * 128 + lc + 4);
#pragma unroll
                    for (int ai = 0; ai < 2; ++ai)
#pragma unroll
                        for (int m = 0; m < 4; ++m) {
                            const f32x4 v0 = (acc[ai][bj][m][0] + bv0) * sc, v1 = (acc[ai][bj][m][1] + bv1) * sc;
                            *(u32x4*)(base + (size_t)(row0 + ai * 128 + m * 16) * D + cb + bj * 128) = pack8(v0, v1);
                        }
                }
            } else if (wc == 0) {
                const f32x4 b0 = *(const f32x4*)(P.BIAS + 3072 + 8 * fq), b1 = *(const f32x4*)(P.BIAS + 3072 + 8 * fq + 4);
#pragma unroll
                for (int ai = 0; ai < 2; ++ai)
#pragma unroll
                    for (int m = 0; m < 4; ++m) {
                        float* gp = P.GATES + (size_t)(row0 + ai * 128 + m * 16) * 32 + 8 * fq;
                        *(f32x4*)gp = acc[ai][0][m][0] + b0; *(f32x4*)(gp + 4) = acc[ai][0][m][1] + b1;
                    }
            }
        } else if constexpr (MODE == 1) {
            const int pn = u.pn;
            const float* bp = P.BIAS + N_STATE_PAD + pn * 256 + lc;
            f32x4 bv[2][2];
#pragma unroll
            for (int bj = 0; bj < 2; ++bj)
#pragma unroll
                for (int n = 0; n < 2; ++n) bv[bj][n] = *(const f32x4*)(bp + bj * 128 + 4 * n);
            if (pn < 24) {
                const int type = pn >> 3, k = pn & 7;
                bf16_t* base = type == 0 ? P.U : (type == 1 ? P.BZ : P.OZ);
                const int cb = k * 128 + lc;
#pragma unroll
                for (int ai = 0; ai < 2; ++ai)
#pragma unroll
                    for (int m = 0; m < 4; ++m) {
                        f32x4 r[2];
#pragma unroll
                        for (int n = 0; n < 2; ++n) {
                            const f32x4 a = acc[ai][0][m][n] + bv[0][n], c = acc[ai][1][m][n] + bv[1][n];
#pragma unroll
                            for (int x = 0; x < 4; ++x) {
                                float o;
                                if (type == 0) o = a[x] * c[x];
                                else if (type == 1) o = a[x] * fsilu(c[x]);
                                else o = c[x] * __builtin_amdgcn_rcpf((1.0f + __expf(-a[x])) * (1.0f + __expf(-c[x])));
                                r[n][x] = o;
                            }
                        }
                        *(u32x4*)(base + (size_t)(row0 + ai * 128 + m * 16) * D + cb) = pack8(r[0], r[1]);
                    }
            } else {
                bf16_t* base = pn < 28 ? P.SGA : P.SGB;
                const int cb = (pn & 3) * 256 + lc;
#pragma unroll
                for (int ai = 0; ai < 2; ++ai)
#pragma unroll
                    for (int m = 0; m < 4; ++m) {
                        bf16_t* rowp = base + (size_t)(row0 + ai * 128 + m * 16) * D + cb;
#pragma unroll
                        for (int bj = 0; bj < 2; ++bj) {
                            f32x4 r[2];
#pragma unroll
                            for (int n = 0; n < 2; ++n) { const f32x4 a = acc[ai][bj][m][n] + bv[bj][n];
#pragma unroll
                                for (int x = 0; x < 4; ++x) r[n][x] = fsigmoid(a[x]); }
                            *(u32x4*)(rowp + bj * 128) = pack8(r[0], r[1]);
                        }
                    }
            }
        } else if constexpr (MODE == 2) {
            if (u.pm < 72) {
                const int cb = u.pn * 256 + lc;
#pragma unroll
                for (int ai = 0; ai < 2; ++ai)
#pragma unroll
                    for (int m = 0; m < 4; ++m) {
                        const size_t ro = (size_t)(row0 + ai * 128 + m * 16) * D + cb;
#pragma unroll
                        for (int bj = 0; bj < 2; ++bj) {
                            f32x4 a0, a1, b0, b1; unpack8(*(const u32x4*)(P.SGA + ro + bj * 128), a0, a1); unpack8(*(const u32x4*)(P.SGB + ro + bj * 128), b0, b1);
#pragma unroll
                            for (int x = 0; x < 4; ++x) { acc[ai][bj][m][0][x] *= a0[x] * __builtin_amdgcn_rcpf(b0[x]); acc[ai][bj][m][1][x] *= a1[x] * __builtin_amdgcn_rcpf(b1[x]); }
                        }
                    }
            } else {
                const int cb = (u.pn - 4) * 256 + lc, r0 = row0 - 72 * 256;
#pragma unroll
                for (int ai = 0; ai < 2; ++ai)
#pragma unroll
                    for (int m = 0; m < 4; ++m) {
                        const size_t ro = (size_t)(r0 + ai * 128 + m * 16) * D + cb;
#pragma unroll
                        for (int bj = 0; bj < 2; ++bj) {
                            f32x4 g0, g1; unpack8(*(const u32x4*)(P.SGB + ro + bj * 128), g0, g1);
                            *(u32x4*)(P.MERGED + ro + bj * 128) = pack8(g0 * acc[ai][bj][m][0], g1 * acc[ai][bj][m][1]);
                        }
                    }
            }
        } else {
            const int cb = u.pn * 256 + lc;
            const int b = u.pm >> 3;
#pragma unroll
            for (int bj = 0; bj < 2; ++bj)
#pragma unroll
                for (int n = 0; n < 2; ++n) {
                    const f32x4 bo = *(const f32x4*)(P.BOUT + cb + bj * 128 + 4 * n), gt = *(const f32x4*)(P.MOD + b * 3072 + 2048 + cb + bj * 128 + 4 * n);
#pragma unroll
                    for (int ai = 0; ai < 2; ++ai)
#pragma unroll
                        for (int m = 0; m < 4; ++m) {
                            const size_t ro = (size_t)(row0 + ai * 128 + m * 16) * D + cb + bj * 128 + 4 * n;
                            const f32x4 xv = *(const f32x4*)(P.X + ro);
                            *(f32x4*)(P.OUT + ro) = xv + gt * (acc[ai][bj][m][n] + bo);
                        }
                }
        }
    }
};

struct Params {
    const float *x, *c, *ctx, *c_ctx, *w_ada, *b_ada, *g_norm, *w_in, *b_in, *w_conv, *b_conv, *g_head, *w_pa, *w_pb, *w_out, *b_out, *g_final;
    float* out; unsigned char* ws;
};

__device__ __forceinline__ int src_col(int n) {
    if (n < 3104) return n;
    if (n < N_STATE_PAD) return -1;
    int r = n - N_STATE_PAD;
    if (r < 6144) {
        const int type = r >> 11, u = (r >> 8) & 7, half = (r >> 7) & 1, x = r & 127;
        int base;
        if (type == 0) base = half ? 7200 : 6176;
        else if (type == 1) base = half ? 8224 : 5152;
        else base = half ? 4128 : 3104;
        return base + 128 * u + x;
    }
    return 9248 + (r - 6144);
}
__device__ __forceinline__ void transpose_item(const float* W, int N, int ncol0  , bf16_t* WT, int row_dst, int k0, LAS float* scr, int lane) {
    if (ncol0 >= 0) {
#pragma unroll 8
        for (int i = 0; i < 32; ++i) { const int kk = 2 * i + (lane >> 5); scr[kk * 33 + (lane & 31)] = W[(size_t)(k0 + kk) * N + ncol0 + (lane & 31)]; }
    } else {
#pragma unroll 8
        for (int i = 0; i < 32; ++i) { const int kk = 2 * i + (lane >> 5); scr[kk * 33 + (lane & 31)] = 0.f; }
    }
    asm volatile("s_waitcnt vmcnt(0) lgkmcnt(0)" ::: "memory");
    const int cch = lane & 7;
#pragma unroll
    for (int j = 0; j < 4; ++j) { const int n = (lane >> 3) + 8 * j; const LAS float* s = scr + (8 * cch) * 33 + n;
        u32x4 o; o.x = cvt_pk_bf16(s[0 * 33], s[1 * 33]); o.y = cvt_pk_bf16(s[2 * 33], s[3 * 33]); o.z = cvt_pk_bf16(s[4 * 33], s[5 * 33]); o.w = cvt_pk_bf16(s[6 * 33], s[7 * 33]);
        *(u32x4*)(WT + (size_t)(row_dst + n) * D + k0 + 8 * cch) = o; }
    asm volatile("s_waitcnt lgkmcnt(0)" ::: "memory");
}

__device__ __forceinline__ int opaque_tid() { int t = threadIdx.x; asm volatile("" : "+v"(t)); return t; }
__device__ __forceinline__ void phase_prep(const Params& p, LAS unsigned char* lds, int G) {
    const int tid = opaque_tid(), lane = tid & 63, wave = tid >> 6;
    unsigned char* ws = p.ws;
    for (int task = blockIdx.x; task < 192; task += G) {
        LAS float* sc = (LAS float*)lds;
        LAS float* red = (LAS float*)(lds + 9 * 1024 * 4);
        {
            float cv[18];
#pragma unroll
            for (int q = 0; q < 18; ++q) { const int i = tid + 512 * q, r = i >> 10, k = i & 1023; cv[q] = r < 8 ? p.c[r * 1024 + k] : p.c_ctx[k]; }
#pragma unroll
            for (int q = 0; q < 18; ++q) sc[tid + 512 * q] = fsilu(cv[q]);
        }
        __syncthreads();
        const int nn = tid & 15, ks = tid >> 4, n0 = task * 16;
        float a[9];
#pragma unroll
        for (int r = 0; r < 9; ++r) a[r] = 0.f;
#pragma unroll
        for (int kb = 0; kb < 4; ++kb) {
            float w[8];
#pragma unroll
            for (int q = 0; q < 8; ++q) w[q] = p.w_ada[(size_t)(ks * 32 + kb * 8 + q) * 3072 + n0 + nn];
#pragma unroll
            for (int q = 0; q < 8; ++q)
#pragma unroll
                for (int r = 0; r < 9; ++r) a[r] += sc[r * 1024 + ks * 32 + kb * 8 + q] * w[q];
        }
#pragma unroll
        for (int r = 0; r < 9; ++r) red[(ks * 9 + r) * 16 + nn] = a[r];
        __syncthreads();
        if (tid < 144) { const int r = tid >> 4; float sum = p.b_ada[n0 + nn];
#pragma unroll
            for (int q = 0; q < 32; ++q) sum += red[(q * 9 + r) * 16 + nn];
            ((float*)(ws + WS_MOD))[r * 3072 + n0 + nn] = sum; }
        __syncthreads();
    }
    for (int i = blockIdx.x * 512 + tid; i < N_PAD; i += G * 512) { const int s = src_col(i); ((float*)(ws + WS_BIAS))[i] = s >= 0 ? p.b_in[s] : 0.f; }
    LAS float* scr = (LAS float*)(lds + wave * 8448);
    const int gw = blockIdx.x * 8 + wave, NGW = G * 8;
    constexpr int I_IN = 16 * (N_PAD / 32), I_SQ = 16 * 32;
    for (int it = gw; it < I_IN + 3 * I_SQ; it += NGW) {
        if (it < I_IN) { const int nb = it >> 4, kb = it & 15; transpose_item(p.w_in, N_IN, src_col(nb * 32), (bf16_t*)(ws + WS_WIN), nb * 32, kb * 64, scr, lane); }
        else { int r = it - I_IN; const int which = r / I_SQ; r -= which * I_SQ; const int nb = r >> 4, kb = r & 15;
            const float* W = which == 0 ? p.w_pa : (which == 1 ? p.w_pb : p.w_out);
            bf16_t* WT = (bf16_t*)(ws + (which == 0 ? WS_WPA : (which == 1 ? WS_WPB : WS_WOUT)));
            transpose_item(W, D, nb * 32, WT, nb * 32, kb * 64, scr, lane); }
    }
}

__device__ __forceinline__ void phase_hx(const Params& p, int G) {
    const int tid = opaque_tid(), lane = tid & 63, wave = tid >> 6;
    const int gw = blockIdx.x * 8 + wave, NGW = G * 8;
    const float* MOD = (const float*)(p.ws + WS_MOD);
    bf16_t* A0 = (bf16_t*)(p.ws + WS_A0);
    const int per = (M_ALL + NGW - 1) / NGW;
    int curb = -1; f32x4 gs[4], sh[4];
    const int mend = min((gw + 1) * per, M_ALL);
    for (int m = gw * per; m < mend; m += 3) {
        f32x4 v[3][4];
#pragma unroll
        for (int q = 0; q < 3; ++q) { const int mm = min(m + q, mend - 1);
            const float* xr = mm < M_LAT ? p.x + (size_t)mm * D : p.ctx + (size_t)(mm - M_LAT) * D;
#pragma unroll
            for (int j = 0; j < 4; ++j) v[q][j] = *(const f32x4*)(xr + (lane + 64 * j) * 4); }
#pragma unroll
        for (int q = 0; q < 3; ++q) { const int mm = m + q; if (mm >= mend) break;
            const int b = mm < M_LAT ? (mm >> 11) : 8;
            if (b != curb) { curb = b;
#pragma unroll
                for (int j = 0; j < 4; ++j) { const int cidx = (lane + 64 * j) * 4;
                    const f32x4 g = *(const f32x4*)(p.g_norm + cidx), sv = *(const f32x4*)(MOD + b * 3072 + 1024 + cidx); sh[j] = *(const f32x4*)(MOD + b * 3072 + cidx); gs[j] = g * (sv + 1.0f); } }
            float ss = 0.f;
#pragma unroll
            for (int j = 0; j < 4; ++j) ss += (v[q][j][0] * v[q][j][0] + v[q][j][1] * v[q][j][1]) + (v[q][j][2] * v[q][j][2] + v[q][j][3] * v[q][j][3]);
            const float rstd = rsqrtf(wave_sum(ss) * (1.0f / D) + EPS);
#pragma unroll
            for (int j = 0; j < 4; ++j) { const f32x4 y = v[q][j] * rstd * gs[j] + sh[j];
                u32x2 o; o.x = cvt_pk_bf16(y[0], y[1]); o.y = cvt_pk_bf16(y[2], y[3]);
                *(u32x2*)(A0 + (size_t)mm * D + (lane + 64 * j) * 4) = o; }
        }
    }
}

constexpr int SQ = 0, SK = 17408, SV = 34816, SKT = 44032, SVT = 62464, SC = 71680, SP = 89088, SA_ = 98304, SM_ = 107520, SB_ = 116736, SN = 125952, SQN = 126464, SRS = 126720;
constexpr int LQ = 272, LV = 144;

template <bool MAXOP> __device__ __forceinline__ float block_excl_scan256(float v, LAS float* buf, int t, float ident) {
    int cur = 0; if (t < 256) buf[t] = v; __syncthreads();
    for (int off = 1; off < 256; off <<= 1) {
        if (t < 256) { float x = buf[cur * 256 + t]; if (t >= off) { const float y = buf[cur * 256 + t - off]; x = MAXOP ? fmaxf(x, y) : x + y; } buf[(cur ^ 1) * 256 + t] = x; }
        __syncthreads(); cur ^= 1;
    }
    const float ex = (t < 256 && t > 0) ? buf[cur * 256 + t - 1] : ident;
    __syncthreads();
    return ex;
}

__device__ __forceinline__ int scan_row(int p, int b, int dir) {
    if (p < CTXL) return M_LAT + b * CTXL + (dir ? CTXL - 1 - p : p);
    const int q = p - CTXL; return b * SEQ + (dir ? SEQ - 1 - q : q);
}

__device__ __forceinline__ void phase_scan(const Params& p, LAS unsigned char* lds, int G) {
    const int tid = opaque_tid(), lane = tid & 63, wave = __builtin_amdgcn_readfirstlane(tid >> 6), fr = lane & 15, fq = lane >> 4;
    const bf16_t* Qg = (const bf16_t*)(p.ws + WS_Q); const bf16_t* Kg = (const bf16_t*)(p.ws + WS_K); const bf16_t* Vg = (const bf16_t*)(p.ws + WS_V);
    const float* GATES = (const float*)(p.ws + WS_GATES);
    LAS float* a_s = (LAS float*)(lds + SA_); LAS float* M_s = (LAS float*)(lds + SM_); LAS float* B_s = (LAS float*)(lds + SB_);
    LAS float* n_s = (LAS float*)(lds + SN); LAS float* qn_s = (LAS float*)(lds + SQN); LAS float* rs_s = (LAS float*)(lds + SRS);
    for (int item = blockIdx.x; item < 256; item += G) {
        const int dvh = item & 1, dir = (item >> 1) & 1, h = (item >> 2) & 7, b = item >> 5;
        bf16_t* Hout = (bf16_t*)(p.ws + (dir ? WS_HB : WS_HF));
        __syncthreads();
        {
            LAS float* buf = (LAS float*)(lds + SQ);
            float iv[9], lf[9]; float run = 0.f;
            if (tid < 256) {
#pragma unroll
                for (int e = 0; e < 9; ++e) { const int row = scan_row(tid * 9 + e, b, dir); const float* gp = GATES + (size_t)row * 32 + dir * 16 + h;
                    iv[e] = gp[0]; const float f = gp[8]; const float l = fminf(f, 0.f) - log1pf(__expf(-fabsf(f))); run += l; lf[e] = run; }
            }
            const float off = block_excl_scan256<false>(run, buf, tid, 0.f);
            float mx = -3.0e38f;
            if (tid < 256) {
#pragma unroll
                for (int e = 0; e < 9; ++e) { lf[e] += off; iv[e] -= lf[e]; mx = fmaxf(mx, iv[e]); }
            }
            const float moff = block_excl_scan256<true>(mx, buf, tid, 0.f);
            if (tid < 256) { float mr = fmaxf(moff, 0.f);
#pragma unroll
                for (int e = 0; e < 9; ++e) { const int pp = tid * 9 + e; mr = fmaxf(mr, iv[e]); a_s[pp] = iv[e]; M_s[pp] = mr; B_s[pp] = lf[e]; } }
            if (tid < 128) n_s[tid] = 0.f;
            for (int i = tid; i < 17408 / 16; i += 512) *(LAS u32x4*)(lds + SC + i * 16) = (u32x4){0u, 0u, 0u, 0u};
        }
        __syncthreads();
        f32x4 cacc[4];
#pragma unroll
        for (int te = 0; te < 4; ++te) cacc[te] = (f32x4){0.f, 0.f, 0.f, 0.f};
        u32x4 rq[2], rk[2], rv;
        const int colqk = h * HD + (tid & 15) * 8, colv = h * HD + dvh * 64 + (tid & 7) * 8;
#define ISSUE_LOADS(P0, EMIT) do { \
            _Pragma("unroll") for (int rep = 0; rep < 2; ++rep) { const size_t row = (size_t)scan_row((P0) + (tid >> 4) + 32 * rep, b, dir); \
                rk[rep] = *(const u32x4*)(Kg + row * D + colqk); \
                if (EMIT) rq[rep] = *(const u32x4*)(Qg + row * D + colqk); } \
            { const size_t row = (size_t)scan_row((P0) + (tid >> 3), b, dir); rv = *(const u32x4*)(Vg + row * D + colv); } } while (0)
        rq[0] = rq[1] = (u32x4){0u, 0u, 0u, 0u};
        ISSUE_LOADS(0, false);
        const int it = wave >> 1, sub = wave & 1;
        for (int ch = 0; ch < LSCAN / 64; ++ch) {
            const int p0 = ch * 64; const bool emit = p0 >= CTXL;
            __syncthreads();
#pragma unroll
            for (int rep = 0; rep < 2; ++rep) { const int r = (tid >> 4) + 32 * rep;
                *(LAS u32x4*)(lds + SK + r * LQ + (tid & 15) * 16) = rk[rep];
                if (emit) *(LAS u32x4*)(lds + SQ + r * LQ + (tid & 15) * 16) = rq[rep]; }
            *(LAS u32x4*)(lds + SV + (tid >> 3) * LV + (tid & 7) * 16) = rv;
            __syncthreads();
            if (ch + 1 < LSCAN / 64) ISSUE_LOADS(p0 + 64, (p0 + 64 >= CTXL));
            const float M_start = p0 > 0 ? M_s[p0 - 1] : 0.f, M_last = M_s[p0 + 63];
            const float decay = __expf(M_start - M_last);
            f32x4 hacc[2]; hacc[0] = (f32x4){0.f, 0.f, 0.f, 0.f}; hacc[1] = hacc[0];
            const int i_loc = it * 16 + fr;
            float M_i = 0.f, w_inter = 0.f;
            if (emit) {
                M_i = M_s[p0 + i_loc]; w_inter = __expf(M_start - M_i);
                f32x4 sacc[2]; sacc[0] = (f32x4){0.f, 0.f, 0.f, 0.f}; sacc[1] = sacc[0];
#pragma unroll
                for (int kk = 0; kk < 4; ++kk) {
                    const bf16x8 bq = *(const LAS bf16x8*)(lds + SQ + i_loc * LQ + (kk * 32 + fq * 8) * 2);
#pragma unroll
                    for (int t2 = 0; t2 < 2; ++t2) {
                        const bf16x8 ak = *(const LAS bf16x8*)(lds + SK + ((sub * 2 + t2) * 16 + fr) * LQ + (kk * 32 + fq * 8) * 2);
                        sacc[t2] = __builtin_amdgcn_mfma_f32_16x16x32_bf16(ak, bq, sacc[t2], 0, 0, 0);
                        const bf16x8 ac = *(const LAS bf16x8*)(lds + SC + ((sub * 2 + t2) * 16 + fr) * LQ + (kk * 32 + fq * 8) * 2);
                        hacc[t2] = __builtin_amdgcn_mfma_f32_16x16x32_bf16(ac, bq, hacc[t2], 0, 0, 0);
                    }
                }
                float rs = 0.f;
#pragma unroll
                for (int t2 = 0; t2 < 2; ++t2) {
                    const int j0 = (sub * 2 + t2) * 16 + 4 * fq;
                    const f32x4 av = *(const LAS f32x4*)(a_s + p0 + j0);
                    float pv[4];
#pragma unroll
                    for (int r = 0; r < 4; ++r) { const float e = (j0 + r <= i_loc) ? __expf(av[r] - M_i) : 0.f; pv[r] = sacc[t2][r] * e; rs += pv[r]; }
                    u32x2 o; o.x = cvt_pk_bf16(pv[0], pv[1]); o.y = cvt_pk_bf16(pv[2], pv[3]);
                    *(LAS u32x2*)(lds + SP + i_loc * LV + j0 * 2) = o;
                    hacc[t2] = hacc[t2] * w_inter;
                }
                rs += __shfl_xor(rs, 16); rs += __shfl_xor(rs, 32);
                if (fq == 0) rs_s[sub * 64 + i_loc] = rs;
                { const int qi = tid >> 3, part = tid & 7;
                    const u32x4 q0 = *(const LAS u32x4*)(lds + SQ + qi * LQ + part * 32), q1 = *(const LAS u32x4*)(lds + SQ + qi * LQ + part * 32 + 16);
                    const LAS float* np = n_s + part * 16;
                    float s = bf_lo(q0.x) * np[0] + bf_hi(q0.x) * np[1] + bf_lo(q0.y) * np[2] + bf_hi(q0.y) * np[3] + bf_lo(q0.z) * np[4] + bf_hi(q0.z) * np[5] + bf_lo(q0.w) * np[6] + bf_hi(q0.w) * np[7]
                            + bf_lo(q1.x) * np[8] + bf_hi(q1.x) * np[9] + bf_lo(q1.y) * np[10] + bf_hi(q1.y) * np[11] + bf_lo(q1.z) * np[12] + bf_hi(q1.z) * np[13] + bf_lo(q1.w) * np[14] + bf_hi(q1.w) * np[15];
                    s += __shfl_xor(s, 1); s += __shfl_xor(s, 2); s += __shfl_xor(s, 4);
                    if (part == 0) qn_s[qi] = s; }
            }
#pragma unroll
            for (int rep = 0; rep < 2; ++rep) { const int id = tid + 512 * rep, d = id & 127, jg = id >> 7, j0 = jg * 8;
                float kv[8];
#pragma unroll
                for (int x = 0; x < 8; ++x) kv[x] = bf1(*(const LAS bf16_t*)(lds + SK + (j0 + x) * LQ + d * 2)) * __expf(a_s[p0 + j0 + x] - M_last);
                u32x4 o; o.x = cvt_pk_bf16(kv[0], kv[1]); o.y = cvt_pk_bf16(kv[2], kv[3]); o.z = cvt_pk_bf16(kv[4], kv[5]); o.w = cvt_pk_bf16(kv[6], kv[7]);
                *(LAS u32x4*)(lds + SKT + d * LV + j0 * 2) = o; }
            { const int e = tid & 63, jg = tid >> 6, j0 = jg * 8; unsigned vv[8];
#pragma unroll
                for (int x = 0; x < 8; ++x) vv[x] = *(const LAS bf16_t*)(lds + SV + (j0 + x) * LV + e * 2);
                u32x4 o; o.x = vv[0] | (vv[1] << 16); o.y = vv[2] | (vv[3] << 16); o.z = vv[4] | (vv[5] << 16); o.w = vv[6] | (vv[7] << 16);
                *(LAS u32x4*)(lds + SVT + e * LV + j0 * 2) = o; }
            __syncthreads();
            if (emit) {
#pragma unroll
                for (int kk = 0; kk < 2; ++kk) {
                    const bf16x8 bp = *(const LAS bf16x8*)(lds + SP + i_loc * LV + (kk * 32 + fq * 8) * 2);
#pragma unroll
                    for (int t2 = 0; t2 < 2; ++t2) {
                        const bf16x8 av = *(const LAS bf16x8*)(lds + SVT + ((sub * 2 + t2) * 16 + fr) * LV + (kk * 32 + fq * 8) * 2);
                        hacc[t2] = __builtin_amdgcn_mfma_f32_16x16x32_bf16(av, bp, hacc[t2], 0, 0, 0);
                    }
                }
                float den = rs_s[i_loc] + rs_s[64 + i_loc] + w_inter * qn_s[i_loc];
                den = fmaxf(fabsf(den), __expf(-(B_s[p0 + i_loc] + M_i)));
                const float rden = __builtin_amdgcn_rcpf(den);
                const size_t orow = (size_t)scan_row(p0 + i_loc, b, dir);
#pragma unroll
                for (int t2 = 0; t2 < 2; ++t2) { const int e0 = (sub * 2 + t2) * 16 + 4 * fq;
                    u32x2 o; o.x = cvt_pk_bf16(hacc[t2][0] * rden, hacc[t2][1] * rden); o.y = cvt_pk_bf16(hacc[t2][2] * rden, hacc[t2][3] * rden);
                    *(u32x2*)(Hout + orow * D + h * HD + dvh * 64 + e0) = o; }
            }
#pragma unroll
            for (int te = 0; te < 4; ++te) cacc[te] = cacc[te] * decay;
#pragma unroll
            for (int kk = 0; kk < 2; ++kk) {
                const bf16x8 ak = *(const LAS bf16x8*)(lds + SKT + (wave * 16 + fr) * LV + (kk * 32 + fq * 8) * 2);
#pragma unroll
                for (int te = 0; te < 4; ++te) {
                    const bf16x8 bv = *(const LAS bf16x8*)(lds + SVT + (te * 16 + fr) * LV + (kk * 32 + fq * 8) * 2);
                    cacc[te] = __builtin_amdgcn_mfma_f32_16x16x32_bf16(ak, bv, cacc[te], 0, 0, 0);
                }
            }
#pragma unroll
            for (int te = 0; te < 4; ++te) { u32x2 o; o.x = cvt_pk_bf16(cacc[te][0], cacc[te][1]); o.y = cvt_pk_bf16(cacc[te][2], cacc[te][3]);
                *(LAS u32x2*)(lds + SC + (te * 16 + fr) * LQ + (wave * 16 + 4 * fq) * 2) = o; }
            if (tid < 128) { float s = 0.f;
#pragma unroll
                for (int g8 = 0; g8 < 8; ++g8) { const u32x4 w = *(const LAS u32x4*)(lds + SKT + tid * LV + g8 * 16);
                    s += (bf_lo(w.x) + bf_hi(w.x)) + (bf_lo(w.y) + bf_hi(w.y)) + (bf_lo(w.z) + bf_hi(w.z)) + (bf_lo(w.w) + bf_hi(w.w)); }
                n_s[tid] = decay * n_s[tid] + s; }
        }
    }
    __syncthreads();
}

__device__ __forceinline__ void phase_mix(const Params& p, int G) {
    const int tid = opaque_tid(), lane = tid & 63, wave = tid >> 6;
    const int gw = blockIdx.x * 8 + wave, NGW = G * 8;
    const bf16_t* U = (const bf16_t*)(p.ws + WS_Q); bf16_t* BZ = (bf16_t*)(p.ws + WS_K); bf16_t* OZ = (bf16_t*)(p.ws + WS_V);
    const bf16_t* HF = (const bf16_t*)(p.ws + WS_HF); const bf16_t* HB = (const bf16_t*)(p.ws + WS_HB);
    const int c0 = lane * 16;
    f32x4 w0[4], w1[4], w2[4], bc[4], gh[4];
#pragma unroll
    for (int j = 0; j < 4; ++j) { w0[j] = *(const f32x4*)(p.w_conv + c0 + 4 * j); w1[j] = *(const f32x4*)(p.w_conv + D + c0 + 4 * j); w2[j] = *(const f32x4*)(p.w_conv + 2 * D + c0 + 4 * j);
        bc[j] = *(const f32x4*)(p.b_conv + c0 + 4 * j); gh[j] = *(const f32x4*)(p.g_head + c0 + 4 * j); }
    const int per = (M_LAT + NGW - 1) / NGW;
    for (int m = gw * per; m < (gw + 1) * per && m < M_LAT; ++m) {
        const int t = m & (SEQ - 1);
        const size_t ro = (size_t)m * D + c0;
        f32x4 uc[4], um[4], up[4], bz[4];
        { f32x4 a, b2; unpack8(*(const u32x4*)(U + ro), a, b2); uc[0] = a; uc[1] = b2; unpack8(*(const u32x4*)(U + ro + 8), a, b2); uc[2] = a; uc[3] = b2; }
        if ((t & 63) != 0) { f32x4 a, b2; unpack8(*(const u32x4*)(U + ro - D), a, b2); um[0] = a; um[1] = b2; unpack8(*(const u32x4*)(U + ro - D + 8), a, b2); um[2] = a; um[3] = b2; }
        else { um[0] = um[1] = um[2] = um[3] = (f32x4){0.f, 0.f, 0.f, 0.f}; }
        if ((t & 63) != 63) { f32x4 a, b2; unpack8(*(const u32x4*)(U + ro + D), a, b2); up[0] = a; up[1] = b2; unpack8(*(const u32x4*)(U + ro + D + 8), a, b2); up[2] = a; up[3] = b2; }
        else { up[0] = up[1] = up[2] = up[3] = (f32x4){0.f, 0.f, 0.f, 0.f}; }
        { f32x4 a, b2; unpack8(*(const u32x4*)(BZ + ro), a, b2); bz[0] = a; bz[1] = b2; unpack8(*(const u32x4*)(BZ + ro + 8), a, b2); bz[2] = a; bz[3] = b2; }
        f32x4 ya[4];
#pragma unroll
        for (int j = 0; j < 4; ++j) ya[j] = bz[j] * (w0[j] * um[j] + w1[j] * uc[j] + w2[j] * up[j] + bc[j]);
        *(u32x4*)(BZ + ro) = pack8(ya[0], ya[1]); *(u32x4*)(BZ + ro + 8) = pack8(ya[2], ya[3]);
        f32x4 hv[4], oz[4];
        { f32x4 a, b2, c2, d2; unpack8(*(const u32x4*)(HF + ro), a, b2); unpack8(*(const u32x4*)(HB + ro), c2, d2); hv[0] = a + c2; hv[1] = b2 + d2;
          unpack8(*(const u32x4*)(HF + ro + 8), a, b2); unpack8(*(const u32x4*)(HB + ro + 8), c2, d2); hv[2] = a + c2; hv[3] = b2 + d2; }
        { f32x4 a, b2; unpack8(*(const u32x4*)(OZ + ro), a, b2); oz[0] = a; oz[1] = b2; unpack8(*(const u32x4*)(OZ + ro + 8), a, b2); oz[2] = a; oz[3] = b2; }
        float ss = 0.f;
#pragma unroll
        for (int j = 0; j < 4; ++j) ss += (hv[j][0] * hv[j][0] + hv[j][1] * hv[j][1]) + (hv[j][2] * hv[j][2] + hv[j][3] * hv[j][3]);
        ss += __shfl_xor(ss, 1); ss += __shfl_xor(ss, 2); ss += __shfl_xor(ss, 4);
        const float rstd = rsqrtf(ss * (1.0f / HD) + EPS);
        f32x4 yb[4];
#pragma unroll
        for (int j = 0; j < 4; ++j) yb[j] = oz[j] * (hv[j] * rstd * gh[j]);
        *(u32x4*)(OZ + ro) = pack8(yb[0], yb[1]); *(u32x4*)(OZ + ro + 8) = pack8(yb[2], yb[3]);
    }
}

__device__ __forceinline__ void phase_final(const Params& p, int G) {
    const int tid = opaque_tid(), lane = tid & 63, wave = tid >> 6;
    const int gw = blockIdx.x * 8 + wave, NGW = G * 8;
    f32x4 gf[4];
#pragma unroll
    for (int j = 0; j < 4; ++j) gf[j] = *(const f32x4*)(p.g_final + (lane + 64 * j) * 4);
    const int per = (M_LAT + NGW - 1) / NGW;
    const int mend = min((gw + 1) * per, M_LAT);
    for (int m = gw * per; m < mend; m += 4) {
        f32x4 v[4][4];
#pragma unroll
        for (int q = 0; q < 4; ++q) { const float* xr = p.out + (size_t)min(m + q, mend - 1) * D;
#pragma unroll
            for (int j = 0; j < 4; ++j) v[q][j] = *(const f32x4*)(xr + (lane + 64 * j) * 4); }
#pragma unroll
        for (int q = 0; q < 4; ++q) { if (m + q >= mend) break;
            float ss = 0.f;
#pragma unroll
            for (int j = 0; j < 4; ++j) ss += (v[q][j][0] * v[q][j][0] + v[q][j][1] * v[q][j][1]) + (v[q][j][2] * v[q][j][2] + v[q][j][3] * v[q][j][3]);
            const float rstd = rsqrtf(wave_sum(ss) * (1.0f / D) + EPS);
            float* xr = p.out + (size_t)(m + q) * D;
#pragma unroll
            for (int j = 0; j < 4; ++j) *(f32x4*)(xr + (lane + 64 * j) * 4) = v[q][j] * rstd * gf[j];
        }
    }
}

#define XB_TMO      128
#define XB_XCNT(j)  (256  + 64 * (j))
#define XB_XSUB(j)  (1280 + 64 * (j))
#define XB_XGEN(j)  (2304 + 64 * (j))
#define XB_TOP      3328
#define XB_TOPGEN   3392
#define XCD_BAR_WORDS 3456
#define XB_SPIN_CAP (1u << 18)
__device__ __forceinline__ unsigned xb_ld(unsigned* p)              { return __hip_atomic_load(p, __ATOMIC_RELAXED, __HIP_MEMORY_SCOPE_AGENT); }
__device__ __forceinline__ unsigned xb_add(unsigned* p, unsigned v) { return __hip_atomic_fetch_add(p, v, __ATOMIC_RELAXED, __HIP_MEMORY_SCOPE_AGENT); }
__device__ __forceinline__ unsigned xb_xcc_id() { return (unsigned)__builtin_amdgcn_s_getreg((3 << 11) | 20) & 0xFu; }
#define XB_SPIN(cond, bar) do { unsigned _sp = 0; while (cond) { __builtin_amdgcn_s_sleep(1); \
    if ((++_sp & 255u) == 0u) { if (xb_ld(&(bar)[XB_TMO])) break; if (_sp > XB_SPIN_CAP) { atomicAdd(&(bar)[XB_TMO], 1u); break; } } } } while (0)
struct XcdBarrier { unsigned* bar; unsigned x; volatile LAS unsigned* st; };
__device__ __forceinline__ XcdBarrier xcd_barrier_post(unsigned* bar, volatile LAS unsigned* st) {
    XcdBarrier b; b.bar = bar; b.x = xb_xcc_id(); b.st = st;
    if (threadIdx.x == 0) (void)xb_add(&bar[XB_XCNT(b.x)], 1u);
    return b;
}
__device__ __forceinline__ void xcd_barrier_complete(unsigned* bar, unsigned x, unsigned& nloc, unsigned& nx) {
    const unsigned G = gridDim.x * gridDim.y * gridDim.z;
    unsigned sum, cnt, mine, sp = 0u;
    for (;;) {
        sum = 0u; cnt = 0u; mine = 0u;
#pragma unroll
        for (unsigned j = 0; j < 16; ++j) { const unsigned c = xb_ld(&bar[XB_XCNT(j)]); sum += c; cnt += (c > 0u) ? 1u : 0u; mine = (j == x) ? c : mine; }
        if (sum == G) break;
        __builtin_amdgcn_s_sleep(1);
        if ((++sp & 255u) == 0u) { if (xb_ld(&bar[XB_TMO])) break; if (sp > XB_SPIN_CAP) { atomicAdd(&bar[XB_TMO], 1u); break; } }
    }
    nloc = mine > 0u ? mine : 1u; nx = cnt > 0u ? cnt : 1u;
}
__device__ __forceinline__ void xcd_barrier(const XcdBarrier& b) {
    asm volatile("s_waitcnt vmcnt(0)" ::: "memory");
    __syncthreads();
    if (threadIdx.x == 0) {
        unsigned* bar = b.bar;
        __builtin_amdgcn_s_waitcnt(0);
        unsigned nloc = b.st[0], nx = b.st[1];
        if (nloc == 0u) { xcd_barrier_complete(bar, b.x, nloc, nx); b.st[0] = nloc; b.st[1] = nx; }
        const unsigned old = xb_add(&bar[XB_XSUB(b.x)], 1u);
        const unsigned gen = old / nloc;
        if (old + 1u == (gen + 1u) * nloc) {
            __builtin_amdgcn_fence(__ATOMIC_RELEASE, "agent");
            asm volatile("s_waitcnt vmcnt(0)" ::: "memory");
            const unsigned og = xb_add(&bar[XB_TOP], 1u);
            const unsigned tg = og / nx;
            if (og + 1u == (tg + 1u) * nx) xb_add(&bar[XB_TOPGEN], 1u);
            else XB_SPIN(xb_ld(&bar[XB_TOPGEN]) == tg, bar);
            __builtin_amdgcn_fence(__ATOMIC_ACQUIRE, "agent");
            xb_add(&bar[XB_XGEN(b.x)], 1u);
            asm volatile("s_waitcnt vmcnt(0)" ::: "memory");
        } else {
            XB_SPIN(xb_ld(&bar[XB_XGEN(b.x)]) == gen, bar);
            __builtin_amdgcn_fence(__ATOMIC_ACQUIRE, "agent");
            asm volatile("s_waitcnt vmcnt(0)" ::: "memory");
        }
    }
    __syncthreads();
}

__global__ void __launch_bounds__(512, 2) fwd_megakernel(Params p) {
    extern __shared__ __attribute__((aligned(16))) unsigned char shm[];
    LAS unsigned char* lds = (LAS unsigned char*)shm;
    cg::grid_group grid = cg::this_grid();
    volatile LAS unsigned* bst = (volatile LAS unsigned*)(lds + LDS_STAGE);
    if (threadIdx.x < 2) bst[threadIdx.x] = 0u;
    __syncthreads();
    const XcdBarrier xbar = xcd_barrier_post((unsigned*)(p.ws + WS_BAR), bst);
    if (p.ws == nullptr) grid.sync();
#define GRID_SYNC() xcd_barrier(xbar)
    const int G = gridDim.x;
    unsigned char* ws = p.ws;
    EpiPtrs E; E.ws = ws; E.out = p.out; E.x = p.x; E.bout = p.b_out;

    phase_prep(p, lds, G);
    GRID_SYNC();
    phase_hx(p, G);
    GRID_SYNC();
    {
        pg8::Gemm g{(const bf16_t*)(ws + WS_A0), (const bf16_t*)(ws + WS_WIN), M_ALL, N_STATE_PAD, D};
        pg8::StateOrder S; S.init(M_LAT, N_STATE_PAD, G, (int)blockIdx.x);
        Epi<0> e{E};
        pg8::gemm_phase(lds, g, S, e);
    }
    GRID_SYNC();
    phase_scan(p, lds, G);
    GRID_SYNC();
    {
        pg8::Gemm g{(const bf16_t*)(ws + WS_A0), (const bf16_t*)(ws + WS_WIN) + (size_t)N_STATE_PAD * D, M_LAT, N_REST, D};
        pg8::StaticOrder S; S.init(M_LAT, N_REST, G, (int)blockIdx.x);
        Epi<1> e{E};
        pg8::gemm_phase(lds, g, S, e);
    }
    GRID_SYNC();
    phase_mix(p, G);
    GRID_SYNC();
    {
        pg8::Gemm g{(const bf16_t*)(ws + WS_K), (const bf16_t*)(ws + WS_WPA), M_LAT, D, D};
        pg8::PairOrder S; S.init(M_LAT, D, G, (int)blockIdx.x);
        Epi<2> e{E};
        pg8::gemm_phase(lds, g, S, e);
    }
    GRID_SYNC();
    {
        pg8::StaticOrder S; S.init(M_LAT, D, G, (int)blockIdx.x);
        pg8::Gemm g{(const bf16_t*)(ws + WS_A0), (const bf16_t*)(ws + WS_WOUT), M_LAT, D, D}; Epi<4> e{E}; pg8::gemm_phase(lds, g, S, e);
    }
    GRID_SYNC();
    GRID_SYNC(); GRID_SYNC(); GRID_SYNC(); GRID_SYNC();
    phase_final(p, G);
}

extern "C" void kernel_launch(void* const* d_in, const int* in_sizes, int n_in, void* d_out, int out_size, void* d_ws, size_t ws_size, hipStream_t stream) {
    static int grid_blocks = 0;
    if (!grid_blocks) {
        int dev = 0, cus = 0, per_cu = 0;
        hipGetDevice(&dev);
        hipDeviceGetAttribute(&cus, hipDeviceAttributeMultiprocessorCount, dev);
        if (hipFuncSetAttribute((const void*)fwd_megakernel, hipFuncAttributeMaxDynamicSharedMemorySize, LDS_BYTES) != hipSuccess) fprintf(stderr, "kernel_launch: hipFuncSetAttribute failed\n");
        if (hipOccupancyMaxActiveBlocksPerMultiprocessor(&per_cu, (const void*)fwd_megakernel, 512, LDS_BYTES) != hipSuccess || per_cu < 1) { fprintf(stderr, "kernel_launch: occupancy query gave %d\n", per_cu); per_cu = 1; }
        grid_blocks = cus * per_cu;
        if (grid_blocks > 256) grid_blocks = 256;
        if (ws_size < WS_END) fprintf(stderr, "kernel_launch: workspace too small: %zu < %zu\n", ws_size, (size_t)WS_END);
    }
    Params p{};
    p.x = (const float*)d_in[0]; p.c = (const float*)d_in[1]; p.ctx = (const float*)d_in[2]; p.c_ctx = (const float*)d_in[3];
    p.w_ada = (const float*)d_in[4]; p.b_ada = (const float*)d_in[5]; p.g_norm = (const float*)d_in[6]; p.w_in = (const float*)d_in[7]; p.b_in = (const float*)d_in[8];
    p.w_conv = (const float*)d_in[9]; p.b_conv = (const float*)d_in[10]; p.g_head = (const float*)d_in[11]; p.w_pa = (const float*)d_in[12]; p.w_pb = (const float*)d_in[13];
    p.w_out = (const float*)d_in[14]; p.b_out = (const float*)d_in[15]; p.g_final = (const float*)d_in[16];
    p.out = (float*)d_out; p.ws = (unsigned char*)d_ws;
    (void)hipMemsetAsync((unsigned char*)d_ws + WS_BAR, 0, XCD_BAR_WORDS * 4, stream);
    void* args[] = {&p};
    hipError_t e = hipLaunchCooperativeKernel((const void*)fwd_megakernel, dim3(grid_blocks), dim3(512), args, LDS_BYTES, stream);
    if (e != hipSuccess) fprintf(stderr, "cooperative launch failed: %s (grid %d)\n", hipGetErrorString(e), grid_blocks);
}
```

```cpp
#include <hip/hip_runtime.h>
#include <hip/hip_cooperative_groups.h>
#include <cstdio>
#include <cstdint>
namespace cg = cooperative_groups;

#define LAS __attribute__((address_space(3)))
typedef unsigned short bf16_t;
typedef short bf16x8 __attribute__((ext_vector_type(8)));
typedef float f32x4 __attribute__((ext_vector_type(4)));
typedef unsigned u32x4 __attribute__((ext_vector_type(4)));
typedef unsigned u32x2 __attribute__((ext_vector_type(2)));

constexpr int D = 1024, NB = 8, SEQ = 2048, CTXL = 256, NH = 8, HD = 128;
constexpr int M_LAT = NB * SEQ, M_CTX = NB * CTXL, M_ALL = M_LAT + M_CTX;
constexpr int N_IN = 11296, N_PAD = 11520, N_STATE_PAD = 3328, N_REST = 8192;
constexpr int LSCAN = CTXL + SEQ;
constexpr float EPS = 1e-6f;
constexpr float QSCALE = 0.08838834764831845f;
constexpr int LDS_STAGE = 131072, LDS_BYTES = LDS_STAGE + 64;

constexpr size_t MiB = 1024 * 1024;
constexpr size_t WS_MOD = 0;
constexpr size_t WS_BIAS = 128 * 1024;
constexpr size_t WS_BAR = 176 * 1024;
constexpr size_t WS_GATES = 192 * 1024;
constexpr size_t WS_WIN = WS_GATES + (size_t)M_ALL * 32 * 4;
constexpr size_t WS_WPA = WS_WIN + (size_t)N_PAD * D * 2;
constexpr size_t WS_WPB = WS_WPA + 2 * MiB;
constexpr size_t WS_WOUT = WS_WPB + 2 * MiB;
constexpr size_t WS_A0 = WS_WOUT + 2 * MiB;
constexpr size_t WS_Q = WS_A0 + 36 * MiB;
constexpr size_t WS_K = WS_Q + 36 * MiB;
constexpr size_t WS_V = WS_K + 36 * MiB;
constexpr size_t WS_HF = WS_V + 36 * MiB;
constexpr size_t WS_HB = WS_HF + 32 * MiB;
constexpr size_t WS_END = WS_HB + 32 * MiB;

typedef __bf16 hbf16x2 __attribute__((ext_vector_type(2)));
typedef float f32x2v __attribute__((ext_vector_type(2)));
__device__ __forceinline__ unsigned cvt_pk_bf16(float lo, float hi) { const hbf16x2 r = __builtin_convertvector((f32x2v){lo, hi}, hbf16x2); return __builtin_bit_cast(unsigned, r); }
__device__ __forceinline__ float bf_lo(unsigned w) { return __uint_as_float(w << 16); }
__device__ __forceinline__ float bf_hi(unsigned w) { return __uint_as_float(w & 0xffff0000u); }
__device__ __forceinline__ float bf1(bf16_t b) { return __uint_as_float(((unsigned)b) << 16); }
__device__ __forceinline__ float fsigmoid(float x) { return __builtin_amdgcn_rcpf(1.0f + __expf(-x)); }
__device__ __forceinline__ float fsilu(float x) { return x * fsigmoid(x); }
__device__ __forceinline__ float wave_sum(float v) {
#pragma unroll
    for (int o = 1; o < 64; o <<= 1) v += __shfl_xor(v, o);
    return v;
}

namespace pg8 {
constexpr int BM = 256, BK = 64, HALF = 128, HTB = HALF * BK * 2, STAGE_BYTES = 8 * HTB, NXCD = 8, WGM = 8;
__host__ __device__ __forceinline__ int lds_byte(int r, int c) { const int st = (r >> 4) * 2 + (c >> 5), rr = r & 15, cc = c & 31, ob = rr * 64 + cc * 2; return st * 1024 + (ob ^ (((ob >> 9) & 1) << 5)); }
__host__ __device__ __forceinline__ void stage_rc(int b, int& R, int& C) { const int st = b / 1024, sb = b % 1024, swz = sb ^ (((sb >> 9) & 1) << 5); R = (st >> 1) * 16 + swz / 64; C = (st & 1) * 32 + (swz % 64) / 2; }
__host__ __device__ __forceinline__ int perm32(int rho) { const int n = rho >> 4, i = rho & 15; return 8 * (i >> 2) + 4 * n + (i & 3); }
struct Unit { int pm, pn; };
struct Gemm { const bf16_t* A; const bf16_t* Bt; int M, N, K; };
struct StaticOrder {
    int nM, nN, nwg, G, c;
    __host__ __device__ void init(int M, int N, int G_, int c_) { nM = M / BM; nN = N / BM; nwg = nM * nN; G = G_; c = c_; }
    __host__ __device__ bool map(long L, Unit& u) const {
        if (L >= nwg) return false;
        int wgid = (int)L; { const int q = nwg / NXCD, r = nwg % NXCD, xcd = wgid % NXCD, off = wgid / NXCD; wgid = (xcd < r ? xcd * (q + 1) : r * (q + 1) + (xcd - r) * q) + off; }
        const int nig = WGM * nN, gid = wgid / nig, fm = gid * WGM, gsz = (nM - fm) < WGM ? (nM - fm) : WGM;
        u.pm = fm + ((wgid % nig) % gsz); u.pn = (wgid % nig) / gsz; return true;
    }
    __host__ __device__ bool next(int i, Unit& u) const { return map((long)i * G + c, u); }
    __device__ __forceinline__ void a_ready(const Unit&) const {}
    __device__ __forceinline__ void done(const Unit&) const {}
};
struct StateOrder : StaticOrder {
    __host__ __device__ bool next(int i, Unit& u) const {
        const long L = (long)i * G + c;
        if (L < nwg) return map(L, u);
        const int idx = (int)(L - nwg); if (idx >= 72) return false;
        u.pm = 64 + (idx & 7); u.pn = 4 + (idx >> 3); return true;
    }
};

struct PairOrder : StaticOrder {
    __host__ __device__ bool next(int i, Unit& u) const {
        if (!map((long)(i >> 1) * G + c, u)) return false;
        if (i & 1) { u.pm += 72; u.pn += 4; }
        return true;
    }
};

template <class Epi, class Sched>
__device__ __forceinline__ void gemm_phase(LAS unsigned char* lds, const Gemm g, const Sched& S, const Epi& E) {
    int tid = threadIdx.x; asm volatile("" : "+v"(tid));
    const int wid = __builtin_amdgcn_readfirstlane(tid >> 6), lane = tid & 63, wr = wid >> 2, wc = wid & 3, fr = lane & 15, fq = lane >> 4;
    const int K = g.K, nt = K / BK;
    unsigned voffA[2], voffB[2];
#pragma unroll
    for (int i = 0; i < 2; ++i) { int R, C; stage_rc(tid * 16 + i * 8192, R, C); const int Rb = Epi::PERM ? ((R & ~31) + perm32(R & 31)) : R;
        voffA[i] = (unsigned)(R * K + C) * 2u; voffB[i] = (unsigned)(Rb * K + C) * 2u; }
    const size_t kstep = (size_t)(BK * 2);
    const size_t hstep = (size_t)HALF * K * 2;
    const size_t tstep = 2 * hstep;
    const unsigned ldsw = (unsigned)wid * 1024u;
    const int aoff = lds_byte(wr * 64 + fr, fq * 8), boff = lds_byte(wc * 32 + fr, fq * 8);
#define PG8_SA(b, h) (((b) * 2 + (h)) * HTB)
#define PG8_SB(b, h) ((4 + (b) * 2 + (h)) * HTB)
#define PG8_STAGE(bufoff, gbase, voff) do { _Pragma("unroll") for (int _i = 0; _i < 2; ++_i) \
        __builtin_amdgcn_global_load_lds((const unsigned*)((const char*)(gbase) + (voff)[_i]), (LAS unsigned*)(lds + (bufoff) + ldsw + _i * 8192), 16, 0, 0); } while (0)
#define PG8_LDA(dst, b, h) do { _Pragma("unroll") for (int m = 0; m < 4; ++m) _Pragma("unroll") for (int k = 0; k < 2; ++k) dst[m][k] = *(const LAS bf16x8*)(lds + PG8_SA(b, h) + aoff + m * 2048 + k * 1024); } while (0)
#define PG8_LDB(dst, b, h) do { _Pragma("unroll") for (int n = 0; n < 2; ++n) _Pragma("unroll") for (int k = 0; k < 2; ++k) dst[n][k] = *(const LAS bf16x8*)(lds + PG8_SB(b, h) + boff + n * 2048 + k * 1024); } while (0)
#define PG8_MMA(ai, bj, At, Bt) do { __builtin_amdgcn_s_setprio(1); _Pragma("unroll") for (int m = 0; m < 4; ++m) _Pragma("unroll") for (int n = 0; n < 2; ++n) _Pragma("unroll") for (int k = 0; k < 2; ++k) \
        acc[ai][bj][m][n] = __builtin_amdgcn_mfma_f32_16x16x32_bf16(Bt[n][k], At[m][k], acc[ai][bj][m][n], 0, 0, 0); __builtin_amdgcn_s_setprio(0); } while (0)
#define PG8_WAIT_V(n) asm volatile("s_waitcnt vmcnt(" #n ")" ::: "memory")
#define PG8_WAIT_L(n) asm volatile("s_waitcnt lgkmcnt(" #n ")" ::: "memory")
#define PG8_BAR __builtin_amdgcn_s_barrier()
#define PG8_SCHED __builtin_amdgcn_sched_barrier(0)
    Unit cur, nxt; int ui = 0;
    if (!S.next(0, cur)) return;
    f32x4 acc[2][2][4][2];
#pragma unroll
    for (int a = 0; a < 2; ++a)
#pragma unroll
        for (int b = 0; b < 2; ++b)
#pragma unroll
            for (int m = 0; m < 4; ++m)
#pragma unroll
                for (int n = 0; n < 2; ++n) acc[a][b][m][n] = (f32x4){0.f, 0.f, 0.f, 0.f};
    bf16x8 At[4][2], B0[2][2], B1[2][2];
    const char* cA = (const char*)g.A + (size_t)cur.pm * tstep; const char* cB = (const char*)g.Bt + (size_t)cur.pn * tstep;
    S.a_ready(cur);
    PG8_STAGE(PG8_SB(0, 0), cB, voffB); PG8_STAGE(PG8_SA(0, 0), cA, voffA); PG8_STAGE(PG8_SB(0, 1), cB + hstep, voffB); PG8_STAGE(PG8_SA(0, 1), cA + hstep, voffA);
    if (wr == 1) PG8_BAR;
    PG8_WAIT_V(4); PG8_BAR;
    PG8_STAGE(PG8_SB(1, 0), cB + kstep, voffB); PG8_STAGE(PG8_SA(1, 0), cA + kstep, voffA); PG8_STAGE(PG8_SB(1, 1), cB + hstep + kstep, voffB);
    PG8_WAIT_V(6); PG8_BAR;
    for (;;) {
        const bool has_next = S.next(ui + 1, nxt);
        const char* nA = has_next ? (const char*)g.A + (size_t)nxt.pm * tstep : cA; const char* nB = has_next ? (const char*)g.Bt + (size_t)nxt.pn * tstep : cB;
        for (int t = 0; t < nt; t += 2) {
            const bool last = (t == nt - 2);
            const char* a1 = cA + (size_t)(t + 1) * kstep;
            const char* a2 = last ? nA : cA + (size_t)(t + 2) * kstep; const char* b2 = last ? nB : cB + (size_t)(t + 2) * kstep;
            const char* a3 = a2 + kstep; const char* b3 = b2 + kstep;
            if (last && has_next) S.a_ready(nxt);
            PG8_LDB(B0, 0, 0); PG8_SCHED; PG8_LDA(At, 0, 0); PG8_STAGE(PG8_SA(1, 1), a1 + hstep, voffA);
            PG8_WAIT_L(8); PG8_BAR; PG8_WAIT_L(0); PG8_MMA(0, 0, At, B0); PG8_BAR; PG8_SCHED;
            PG8_LDB(B1, 0, 1); PG8_STAGE(PG8_SB(0, 0), b2, voffB);
            PG8_BAR; PG8_WAIT_L(0); PG8_MMA(0, 1, At, B1); PG8_BAR;
            PG8_LDA(At, 0, 1); PG8_STAGE(PG8_SA(0, 0), a2, voffA);
            PG8_BAR; PG8_WAIT_L(0); PG8_MMA(1, 0, At, B0); PG8_BAR; PG8_SCHED;
            PG8_STAGE(PG8_SB(0, 1), b2 + hstep, voffB);
            PG8_WAIT_V(6); PG8_BAR; PG8_MMA(1, 1, At, B1); PG8_BAR;
            PG8_LDB(B0, 1, 0); PG8_SCHED; PG8_LDA(At, 1, 0); PG8_STAGE(PG8_SA(0, 1), a2 + hstep, voffA);
            PG8_WAIT_L(8); PG8_BAR; PG8_WAIT_L(0); PG8_MMA(0, 0, At, B0); PG8_BAR; PG8_SCHED;
            PG8_LDB(B1, 1, 1); PG8_STAGE(PG8_SB(1, 0), b3, voffB);
            PG8_BAR; PG8_WAIT_L(0); PG8_MMA(0, 1, At, B1); PG8_BAR;
            PG8_LDA(At, 1, 1); PG8_STAGE(PG8_SA(1, 0), a3, voffA);
            PG8_BAR; PG8_WAIT_L(0); PG8_MMA(1, 0, At, B0); PG8_BAR; PG8_SCHED;
            PG8_STAGE(PG8_SB(1, 1), b3 + hstep, voffB);
            PG8_WAIT_V(6); PG8_BAR; PG8_MMA(1, 1, At, B1); PG8_BAR;
        }
        E(acc, cur, wr, wc, fr, fq); S.done(cur);
        if (!has_next) break;
        if (!E.keep(cur)) {
#pragma unroll
            for (int a = 0; a < 2; ++a)
#pragma unroll
                for (int b = 0; b < 2; ++b)
#pragma unroll
                    for (int m = 0; m < 4; ++m)
#pragma unroll
                        for (int n = 0; n < 2; ++n) acc[a][b][m][n] = (f32x4){0.f, 0.f, 0.f, 0.f};
        }
        cur = nxt; cA = nA; cB = nB; ++ui;
    }
    PG8_WAIT_V(0);
    if (wr == 0) PG8_BAR;
    PG8_BAR;
#undef PG8_SA
#undef PG8_SB
#undef PG8_STAGE
#undef PG8_LDA
#undef PG8_LDB
#undef PG8_MMA
#undef PG8_WAIT_V
#undef PG8_WAIT_L
#undef PG8_BAR
#undef PG8_SCHED
}
}

struct EpiPtrs { unsigned char* ws; float* out; const float* x; const float* bout; };
struct EpiView {
    bf16_t *Q, *K, *V, *U, *BZ, *OZ, *SGA, *SGB, *MERGED;
    float *GATES, *TMP, *OUT;
    const float *BIAS, *X, *MOD, *BOUT;
    __device__ __forceinline__ EpiView(const EpiPtrs& e) {
        unsigned char* ws = e.ws;
        Q = (bf16_t*)(ws + WS_Q); K = (bf16_t*)(ws + WS_K); V = (bf16_t*)(ws + WS_V); U = Q; BZ = K; OZ = V;
        SGA = (bf16_t*)e.out; SGB = (bf16_t*)e.out + (size_t)M_LAT * D; MERGED = (bf16_t*)(ws + WS_A0);
        GATES = (float*)(ws + WS_GATES); TMP = (float*)(ws + WS_HF); OUT = e.out;
        BIAS = (const float*)(ws + WS_BIAS); X = e.x; MOD = (const float*)(ws + WS_MOD); BOUT = e.bout;
    }
};
__device__ __forceinline__ u32x4 pack8(const f32x4 a, const f32x4 b) { u32x4 w; w.x = cvt_pk_bf16(a[0], a[1]); w.y = cvt_pk_bf16(a[2], a[3]); w.z = cvt_pk_bf16(b[0], b[1]); w.w = cvt_pk_bf16(b[2], b[3]); return w; }
__device__ __forceinline__ void unpack8(const u32x4 w, f32x4& a, f32x4& b) { a = (f32x4){bf_lo(w.x), bf_hi(w.x), bf_lo(w.y), bf_hi(w.y)}; b = (f32x4){bf_lo(w.z), bf_hi(w.z), bf_lo(w.w), bf_hi(w.w)}; }

template <int T> __device__ __forceinline__ void fused_pair(const f32x4 (&acc)[2][2][4][2], const f32x4 (&bv)[2][2], bf16_t* base) {
#pragma unroll
    for (int ai = 0; ai < 2; ++ai)
#pragma unroll
        for (int m = 0; m < 4; ++m) {
            f32x4 r[2];
#pragma unroll
            for (int n = 0; n < 2; ++n) {
                const f32x4 a = acc[ai][0][m][n] + bv[0][n], c = acc[ai][1][m][n] + bv[1][n];
#pragma unroll
                for (int x = 0; x < 4; ++x) {
                    if (T == 0) r[n][x] = a[x] * c[x];
                    else if (T == 1) r[n][x] = a[x] * c[x] * __builtin_amdgcn_rcpf(1.0f + __expf(-c[x]));
                    else r[n][x] = c[x] * __builtin_amdgcn_rcpf((1.0f + __expf(-a[x])) * (1.0f + __expf(-c[x])));
                }
            }
            *(u32x4*)(base + (size_t)(ai * 128 + m * 16) * D) = pack8(r[0], r[1]);
        }
}

template <int MODE> struct Epi {
    static constexpr bool PERM = true;
    EpiPtrs PP;
    __device__ __forceinline__ bool keep(const pg8::Unit& u) const { return MODE == 2 && u.pm < 72; }
    __device__ __forceinline__ void operator()(f32x4 (&acc)[2][2][4][2], const pg8::Unit& u, int wr, int wc, int fr, int fq) const {
        const EpiView P(PP);
        const int row0 = u.pm * 256 + wr * 64 + fr;
        const int lc = wc * 32 + 8 * fq;
        if constexpr (MODE == 0) {
            const int pn = u.pn;
            if (pn < 12) {
                bf16_t* base = pn < 4 ? P.Q : (pn < 8 ? P.K : P.V);
                const float sc = pn < 4 ? QSCALE : 1.0f;
                const int cb = (pn & 3) * 256 + lc;
#pragma unroll
                for (int bj = 0; bj < 2; ++bj) {
                    const f32x4 bv0 = *(const f32x4*)(P.BIAS + pn * 256 + bj * 128 + lc), bv1 = *(const f32x4*)(P.BIAS + pn * 256 + bj * 128 + lc + 4);
#pragma unroll
                    for (int ai = 0; ai < 2; ++ai)
#pragma unroll
                        for (int m = 0; m < 4; ++m) {
                            const f32x4 v0 = (acc[ai][bj][m][0] + bv0) * sc, v1 = (acc[ai][bj][m][1] + bv1) * sc;
                            *(u32x4*)(base + (size_t)(row0 + ai * 128 + m * 16) * D + cb + bj * 128) = pack8(v0, v1);
                        }
                }
            } else if (wc == 0) {
                const f32x4 b0 = *(const f32x4*)(P.BIAS + 3072 + 8 * fq), b1 = *(const f32x4*)(P.BIAS + 3072 + 8 * fq + 4);
#pragma unroll
                for (int ai = 0; ai < 2; ++ai)
#pragma unroll
                    for (int m = 0; m < 4; ++m) {
                        float* gp = P.GATES + (size_t)(row0 + ai * 128 + m * 16) * 32 + 8 * fq;
                        *(f32x4*)gp = acc[ai][0][m][0] + b0; *(f32x4*)(gp + 4) = acc[ai][0][m][1] + b1;
                    }
            }
        } else if constexpr (MODE == 1) {
            const int pn = u.pn;
            const float* bp = P.BIAS + N_STATE_PAD + pn * 256 + lc;
            f32x4 bv[2][2];
#pragma unroll
            for (int bj = 0; bj < 2; ++bj)
#pragma unroll
                for (int n = 0; n < 2; ++n) bv[bj][n] = *(const f32x4*)(bp + bj * 128 + 4 * n);
            if (pn < 24) {
                const int type = pn >> 3, k = pn & 7;
                bf16_t* base = (type == 0 ? P.U : (type == 1 ? P.BZ : P.OZ)) + (size_t)row0 * D + k * 128 + lc;
                if (type == 0) fused_pair<0>(acc, bv, base); else if (type == 1) fused_pair<1>(acc, bv, base); else fused_pair<2>(acc, bv, base);
            } else {
                bf16_t* base = pn < 28 ? P.SGA : P.SGB;
                const int cb = (pn & 3) * 256 + lc;
#pragma unroll
                for (int ai = 0; ai < 2; ++ai)
#pragma unroll
                    for (int m = 0; m < 4; ++m) {
                        bf16_t* rowp = base + (size_t)(row0 + ai * 128 + m * 16) * D + cb;
#pragma unroll
                        for (int bj = 0; bj < 2; ++bj) {
                            f32x4 r[2];
#pragma unroll
                            for (int n = 0; n < 2; ++n) { const f32x4 a = acc[ai][bj][m][n] + bv[bj][n];
#pragma unroll
                                for (int x = 0; x < 4; ++x) r[n][x] = fsigmoid(a[x]); }
                            *(u32x4*)(rowp + bj * 128) = pack8(r[0], r[1]);
                        }
                    }
            }
        } else if constexpr (MODE == 2) {
            if (u.pm < 72) {
                const int cb = u.pn * 256 + lc;
#pragma unroll
                for (int ai = 0; ai < 2; ++ai)
#pragma unroll
                    for (int m = 0; m < 4; ++m) {
                        const size_t ro = (size_t)(row0 + ai * 128 + m * 16) * D + cb;
#pragma unroll
                        for (int bj = 0; bj < 2; ++bj) {
                            f32x4 a0, a1, b0, b1; unpack8(*(const u32x4*)(P.SGA + ro + bj * 128), a0, a1); unpack8(*(const u32x4*)(P.SGB + ro + bj * 128), b0, b1);
#pragma unroll
                            for (int x = 0; x < 4; ++x) { acc[ai][bj][m][0][x] *= a0[x] * __builtin_amdgcn_rcpf(b0[x]); acc[ai][bj][m][1][x] *= a1[x] * __builtin_amdgcn_rcpf(b1[x]); }
                        }
                    }
            } else {
                const int cb = (u.pn - 4) * 256 + lc, r0 = row0 - 72 * 256;
#pragma unroll
                for (int ai = 0; ai < 2; ++ai)
#pragma unroll
                    for (int m = 0; m < 4; ++m) {
                        const size_t ro = (size_t)(r0 + ai * 128 + m * 16) * D + cb;
#pragma unroll
                        for (int bj = 0; bj < 2; ++bj) {
                            f32x4 g0, g1; unpack8(*(const u32x4*)(P.SGB + ro + bj * 128), g0, g1);
                            *(u32x4*)(P.MERGED + ro + bj * 128) = pack8(g0 * acc[ai][bj][m][0], g1 * acc[ai][bj][m][1]);
                        }
                    }
            }
        } else {
            const int cb = u.pn * 256 + lc;
            const int b = u.pm >> 3;
#pragma unroll
            for (int bj = 0; bj < 2; ++bj) {
                const f32x4 bo0 = *(const f32x4*)(P.BOUT + cb + bj * 128), bo1 = *(const f32x4*)(P.BOUT + cb + bj * 128 + 4);
                const f32x4 gt0 = *(const f32x4*)(P.MOD + b * 3072 + 2048 + cb + bj * 128), gt1 = *(const f32x4*)(P.MOD + b * 3072 + 2048 + cb + bj * 128 + 4);
#pragma unroll
                for (int ai = 0; ai < 2; ++ai) {
                    f32x4 xv[4][2];
#pragma unroll
                    for (int m = 0; m < 4; ++m) { const size_t ro = (size_t)(row0 + ai * 128 + m * 16) * D + cb + bj * 128;
                        xv[m][0] = *(const f32x4*)(P.X + ro); xv[m][1] = *(const f32x4*)(P.X + ro + 4); }
#pragma unroll
                    for (int m = 0; m < 4; ++m) { const size_t ro = (size_t)(row0 + ai * 128 + m * 16) * D + cb + bj * 128;
                        *(f32x4*)(P.OUT + ro) = xv[m][0] + gt0 * (acc[ai][bj][m][0] + bo0);
                        *(f32x4*)(P.OUT + ro + 4) = xv[m][1] + gt1 * (acc[ai][bj][m][1] + bo1); }
                }
            }
        }
    }
};

struct Params {
    const float *x, *c, *ctx, *c_ctx, *w_ada, *b_ada, *g_norm, *w_in, *b_in, *w_conv, *b_conv, *g_head, *w_pa, *w_pb, *w_out, *b_out, *g_final;
    float* out; unsigned char* ws;
};

__device__ __forceinline__ int src_col(int n) {
    if (n < 3104) return n;
    if (n < N_STATE_PAD) return -1;
    int r = n - N_STATE_PAD;
    if (r < 6144) {
        const int type = r >> 11, u = (r >> 8) & 7, half = (r >> 7) & 1, x = r & 127;
        int base;
        if (type == 0) base = half ? 7200 : 6176;
        else if (type == 1) base = half ? 8224 : 5152;
        else base = half ? 4128 : 3104;
        return base + 128 * u + x;
    }
    return 9248 + (r - 6144);
}
__device__ __forceinline__ void transpose_item(const float* W, int N, int ncol0  , bf16_t* WT, int row_dst, int k0, LAS float* scr, int lane) {
    if (ncol0 >= 0) {
#pragma unroll 8
        for (int i = 0; i < 32; ++i) { const int kk = 2 * i + (lane >> 5); scr[kk * 33 + (lane & 31)] = W[(size_t)(k0 + kk) * N + ncol0 + (lane & 31)]; }
    } else {
#pragma unroll 8
        for (int i = 0; i < 32; ++i) { const int kk = 2 * i + (lane >> 5); scr[kk * 33 + (lane & 31)] = 0.f; }
    }
    asm volatile("s_waitcnt vmcnt(0) lgkmcnt(0)" ::: "memory");
    const int cch = lane & 7;
#pragma unroll
    for (int j = 0; j < 4; ++j) { const int n = (lane >> 3) + 8 * j; const LAS float* s = scr + (8 * cch) * 33 + n;
        u32x4 o; o.x = cvt_pk_bf16(s[0 * 33], s[1 * 33]); o.y = cvt_pk_bf16(s[2 * 33], s[3 * 33]); o.z = cvt_pk_bf16(s[4 * 33], s[5 * 33]); o.w = cvt_pk_bf16(s[6 * 33], s[7 * 33]);
        *(u32x4*)(WT + (size_t)(row_dst + n) * D + k0 + 8 * cch) = o; }
    asm volatile("s_waitcnt lgkmcnt(0)" ::: "memory");
}

__device__ __forceinline__ int opaque_tid() { int t = threadIdx.x; asm volatile("" : "+v"(t)); return t; }
__device__ __forceinline__ void phase_prep(const Params& p, LAS unsigned char* lds, int G) {
    const int tid = opaque_tid(), lane = tid & 63, wave = tid >> 6;
    unsigned char* ws = p.ws;
    for (int task = blockIdx.x; task < 192; task += G) {
        LAS float* sc = (LAS float*)lds;
        LAS float* red = (LAS float*)(lds + 9 * 1024 * 4);
        {
            float cv[18];
#pragma unroll
            for (int q = 0; q < 18; ++q) { const int i = tid + 512 * q, r = i >> 10, k = i & 1023; cv[q] = r < 8 ? p.c[r * 1024 + k] : p.c_ctx[k]; }
#pragma unroll
            for (int q = 0; q < 18; ++q) sc[tid + 512 * q] = fsilu(cv[q]);
        }
        __syncthreads();
        const int nn = tid & 15, ks = tid >> 4, n0 = task * 16;
        float a[9];
#pragma unroll
        for (int r = 0; r < 9; ++r) a[r] = 0.f;
#pragma unroll
        for (int kb = 0; kb < 4; ++kb) {
            float w[8];
#pragma unroll
            for (int q = 0; q < 8; ++q) w[q] = p.w_ada[(size_t)(ks * 32 + kb * 8 + q) * 3072 + n0 + nn];
#pragma unroll
            for (int q = 0; q < 8; ++q)
#pragma unroll
                for (int r = 0; r < 9; ++r) a[r] += sc[r * 1024 + ks * 32 + kb * 8 + q] * w[q];
        }
#pragma unroll
        for (int r = 0; r < 9; ++r) red[(ks * 9 + r) * 16 + nn] = a[r];
        __syncthreads();
        if (tid < 144) { const int r = tid >> 4; float sum = p.b_ada[n0 + nn];
#pragma unroll
            for (int q = 0; q < 32; ++q) sum += red[(q * 9 + r) * 16 + nn];
            ((float*)(ws + WS_MOD))[r * 3072 + n0 + nn] = sum; }
        __syncthreads();
    }
    for (int i = blockIdx.x * 512 + tid; i < N_PAD; i += G * 512) { const int s = src_col(i); ((float*)(ws + WS_BIAS))[i] = s >= 0 ? p.b_in[s] : 0.f; }
    LAS float* scr = (LAS float*)(lds + wave * 8448);
    const int gw = blockIdx.x * 8 + wave, NGW = G * 8;
    constexpr int I_IN = 16 * (N_PAD / 32), I_SQ = 16 * 32;
    for (int it = gw; it < I_IN + 3 * I_SQ; it += NGW) {
        if (it < I_IN) { const int nb = it >> 4, kb = it & 15; transpose_item(p.w_in, N_IN, src_col(nb * 32), (bf16_t*)(ws + WS_WIN), nb * 32, kb * 64, scr, lane); }
        else { int r = it - I_IN; const int which = r / I_SQ; r -= which * I_SQ; const int nb = r >> 4, kb = r & 15;
            const float* W = which == 0 ? p.w_pa : (which == 1 ? p.w_pb : p.w_out);
            bf16_t* WT = (bf16_t*)(ws + (which == 0 ? WS_WPA : (which == 1 ? WS_WPB : WS_WOUT)));
            transpose_item(W, D, nb * 32, WT, nb * 32, kb * 64, scr, lane); }
    }
}

__device__ __forceinline__ void phase_hx(const Params& p, int G) {
    const int tid = opaque_tid(), lane = tid & 63, wave = tid >> 6;
    const int gw = blockIdx.x * 8 + wave, NGW = G * 8;
    const float* MOD = (const float*)(p.ws + WS_MOD);
    bf16_t* A0 = (bf16_t*)(p.ws + WS_A0);
    const int per = (M_ALL + NGW - 1) / NGW;
    int curb = -1; f32x4 gs[4], sh[4];
    const int mend = min((gw + 1) * per, M_ALL);
    for (int m = gw * per; m < mend; m += 3) {
        f32x4 v[3][4];
#pragma unroll
        for (int q = 0; q < 3; ++q) { const int mm = min(m + q, mend - 1);
            const float* xr = mm < M_LAT ? p.x + (size_t)mm * D : p.ctx + (size_t)(mm - M_LAT) * D;
#pragma unroll
            for (int j = 0; j < 4; ++j) v[q][j] = *(const f32x4*)(xr + (lane + 64 * j) * 4); }
#pragma unroll
        for (int q = 0; q < 3; ++q) { const int mm = m + q; if (mm >= mend) break;
            const int b = mm < M_LAT ? (mm >> 11) : 8;
            if (b != curb) { curb = b;
#pragma unroll
                for (int j = 0; j < 4; ++j) { const int cidx = (lane + 64 * j) * 4;
                    const f32x4 g = *(const f32x4*)(p.g_norm + cidx), sv = *(const f32x4*)(MOD + b * 3072 + 1024 + cidx); sh[j] = *(const f32x4*)(MOD + b * 3072 + cidx); gs[j] = g * (sv + 1.0f); } }
            float ss = 0.f;
#pragma unroll
            for (int j = 0; j < 4; ++j) ss += (v[q][j][0] * v[q][j][0] + v[q][j][1] * v[q][j][1]) + (v[q][j][2] * v[q][j][2] + v[q][j][3] * v[q][j][3]);
            const float rstd = rsqrtf(wave_sum(ss) * (1.0f / D) + EPS);
#pragma unroll
            for (int j = 0; j < 4; ++j) { const f32x4 y = v[q][j] * rstd * gs[j] + sh[j];
                u32x2 o; o.x = cvt_pk_bf16(y[0], y[1]); o.y = cvt_pk_bf16(y[2], y[3]);
                *(u32x2*)(A0 + (size_t)mm * D + (lane + 64 * j) * 4) = o; }
        }
    }
}

constexpr int SQ = 0, SK = 17408, SV = 34816, SKT = 44032, SVT = 62464, SC = 71680, SP = 89088, SA_ = 98304, SM_ = 107520, SB_ = 116736, SN = 125952, SQN = 126464, SRS = 126720;
constexpr int LQ = 272, LV = 144;

template <bool MAXOP> __device__ __forceinline__ float block_excl_scan256(float v, LAS float* buf, int t, float ident) {
    int cur = 0; if (t < 256) buf[t] = v; __syncthreads();
    for (int off = 1; off < 256; off <<= 1) {
        if (t < 256) { float x = buf[cur * 256 + t]; if (t >= off) { const float y = buf[cur * 256 + t - off]; x = MAXOP ? fmaxf(x, y) : x + y; } buf[(cur ^ 1) * 256 + t] = x; }
        __syncthreads(); cur ^= 1;
    }
    const float ex = (t < 256 && t > 0) ? buf[cur * 256 + t - 1] : ident;
    __syncthreads();
    return ex;
}

__device__ __forceinline__ int scan_row(int p, int b, int dir) {
    if (p < CTXL) return M_LAT + b * CTXL + (dir ? CTXL - 1 - p : p);
    const int q = p - CTXL; return b * SEQ + (dir ? SEQ - 1 - q : q);
}

__device__ __forceinline__ void phase_scan(const Params& p, LAS unsigned char* lds, int G) {
    const int tid = opaque_tid(), lane = tid & 63, wave = __builtin_amdgcn_readfirstlane(tid >> 6), fr = lane & 15, fq = lane >> 4;
    const bf16_t* Qg = (const bf16_t*)(p.ws + WS_Q); const bf16_t* Kg = (const bf16_t*)(p.ws + WS_K); const bf16_t* Vg = (const bf16_t*)(p.ws + WS_V);
    const float* GATES = (const float*)(p.ws + WS_GATES);
    LAS float* a_s = (LAS float*)(lds + SA_); LAS float* M_s = (LAS float*)(lds + SM_); LAS float* B_s = (LAS float*)(lds + SB_);
    LAS float* n_s = (LAS float*)(lds + SN); LAS float* qn_s = (LAS float*)(lds + SQN); LAS float* rs_s = (LAS float*)(lds + SRS);
    for (int item = blockIdx.x; item < 256; item += G) {
        const int dvh = item & 1, dir = (item >> 1) & 1, h = (item >> 2) & 7, b = item >> 5;
        bf16_t* Hout = (bf16_t*)(p.ws + (dir ? WS_HB : WS_HF));
        __syncthreads();
        {
            LAS float* buf = (LAS float*)(lds + SQ);
            float iv[9], lf[9]; float run = 0.f;
            if (tid < 256) {
#pragma unroll
                for (int e = 0; e < 9; ++e) { const int row = scan_row(tid * 9 + e, b, dir); const float* gp = GATES + (size_t)row * 32 + dir * 16 + h;
                    iv[e] = gp[0]; const float f = gp[8]; const float l = fminf(f, 0.f) - log1pf(__expf(-fabsf(f))); run += l; lf[e] = run; }
            }
            const float off = block_excl_scan256<false>(run, buf, tid, 0.f);
            float mx = -3.0e38f;
            if (tid < 256) {
#pragma unroll
                for (int e = 0; e < 9; ++e) { lf[e] += off; iv[e] -= lf[e]; mx = fmaxf(mx, iv[e]); }
            }
            const float moff = block_excl_scan256<true>(mx, buf, tid, 0.f);
            if (tid < 256) { float mr = fmaxf(moff, 0.f);
#pragma unroll
                for (int e = 0; e < 9; ++e) { const int pp = tid * 9 + e; mr = fmaxf(mr, iv[e]); a_s[pp] = iv[e]; M_s[pp] = mr; B_s[pp] = lf[e]; } }
            if (tid < 128) n_s[tid] = 0.f;
            for (int i = tid; i < 17408 / 16; i += 512) *(LAS u32x4*)(lds + SC + i * 16) = (u32x4){0u, 0u, 0u, 0u};
        }
        __syncthreads();
        f32x4 cacc[4];
#pragma unroll
        for (int te = 0; te < 4; ++te) cacc[te] = (f32x4){0.f, 0.f, 0.f, 0.f};
        u32x4 rq[2], rk[2], rv;
        const int colqk = h * HD + (tid & 15) * 8, colv = h * HD + dvh * 64 + (tid & 7) * 8;
#define ISSUE_LOADS(P0, EMIT) do { \
            _Pragma("unroll") for (int rep = 0; rep < 2; ++rep) { const size_t row = (size_t)scan_row((P0) + (tid >> 4) + 32 * rep, b, dir); \
                rk[rep] = *(const u32x4*)(Kg + row * D + colqk); \
                if (EMIT) rq[rep] = *(const u32x4*)(Qg + row * D + colqk); } \
            { const size_t row = (size_t)scan_row((P0) + (tid >> 3), b, dir); rv = *(const u32x4*)(Vg + row * D + colv); } } while (0)
        rq[0] = rq[1] = (u32x4){0u, 0u, 0u, 0u};
        ISSUE_LOADS(0, false);
        const int it = wave >> 1, sub = wave & 1;
        for (int ch = 0; ch < LSCAN / 64; ++ch) {
            const int p0 = ch * 64; const bool emit = p0 >= CTXL;
            __syncthreads();
#pragma unroll
            for (int rep = 0; rep < 2; ++rep) { const int r = (tid >> 4) + 32 * rep;
                *(LAS u32x4*)(lds + SK + r * LQ + (tid & 15) * 16) = rk[rep];
                if (emit) *(LAS u32x4*)(lds + SQ + r * LQ + (tid & 15) * 16) = rq[rep]; }
            *(LAS u32x4*)(lds + SV + (tid >> 3) * LV + (tid & 7) * 16) = rv;
            __syncthreads();
            if (ch + 1 < LSCAN / 64) ISSUE_LOADS(p0 + 64, (p0 + 64 >= CTXL));
            const float M_start = p0 > 0 ? M_s[p0 - 1] : 0.f, M_last = M_s[p0 + 63];
            const float decay = __expf(M_start - M_last);
            f32x4 hacc[2]; hacc[0] = (f32x4){0.f, 0.f, 0.f, 0.f}; hacc[1] = hacc[0];
            const int i_loc = it * 16 + fr;
            float M_i = 0.f, w_inter = 0.f;
            if (emit) {
                M_i = M_s[p0 + i_loc]; w_inter = __expf(M_start - M_i);
                f32x4 sacc[2]; sacc[0] = (f32x4){0.f, 0.f, 0.f, 0.f}; sacc[1] = sacc[0];
#pragma unroll
                for (int kk = 0; kk < 4; ++kk) {
                    const bf16x8 bq = *(const LAS bf16x8*)(lds + SQ + i_loc * LQ + (kk * 32 + fq * 8) * 2);
#pragma unroll
                    for (int t2 = 0; t2 < 2; ++t2) {
                        const bf16x8 ak = *(const LAS bf16x8*)(lds + SK + ((sub * 2 + t2) * 16 + fr) * LQ + (kk * 32 + fq * 8) * 2);
                        sacc[t2] = __builtin_amdgcn_mfma_f32_16x16x32_bf16(ak, bq, sacc[t2], 0, 0, 0);
                        const bf16x8 ac = *(const LAS bf16x8*)(lds + SC + ((sub * 2 + t2) * 16 + fr) * LQ + (kk * 32 + fq * 8) * 2);
                        hacc[t2] = __builtin_amdgcn_mfma_f32_16x16x32_bf16(ac, bq, hacc[t2], 0, 0, 0);
                    }
                }
                float rs = 0.f;
#pragma unroll
                for (int t2 = 0; t2 < 2; ++t2) {
                    const int j0 = (sub * 2 + t2) * 16 + 4 * fq;
                    const f32x4 av = *(const LAS f32x4*)(a_s + p0 + j0);
                    float pv[4];
#pragma unroll
                    for (int r = 0; r < 4; ++r) { const float e = (j0 + r <= i_loc) ? __expf(av[r] - M_i) : 0.f; pv[r] = sacc[t2][r] * e; rs += pv[r]; }
                    u32x2 o; o.x = cvt_pk_bf16(pv[0], pv[1]); o.y = cvt_pk_bf16(pv[2], pv[3]);
                    *(LAS u32x2*)(lds + SP + i_loc * LV + j0 * 2) = o;
                    hacc[t2] = hacc[t2] * w_inter;
                }
                rs += __shfl_xor(rs, 16); rs += __shfl_xor(rs, 32);
                if (fq == 0) rs_s[sub * 64 + i_loc] = rs;
                { const int qi = tid >> 3, part = tid & 7;
                    const u32x4 q0 = *(const LAS u32x4*)(lds + SQ + qi * LQ + part * 32), q1 = *(const LAS u32x4*)(lds + SQ + qi * LQ + part * 32 + 16);
                    const LAS float* np = n_s + part * 16;
                    float s = bf_lo(q0.x) * np[0] + bf_hi(q0.x) * np[1] + bf_lo(q0.y) * np[2] + bf_hi(q0.y) * np[3] + bf_lo(q0.z) * np[4] + bf_hi(q0.z) * np[5] + bf_lo(q0.w) * np[6] + bf_hi(q0.w) * np[7]
                            + bf_lo(q1.x) * np[8] + bf_hi(q1.x) * np[9] + bf_lo(q1.y) * np[10] + bf_hi(q1.y) * np[11] + bf_lo(q1.z) * np[12] + bf_hi(q1.z) * np[13] + bf_lo(q1.w) * np[14] + bf_hi(q1.w) * np[15];
                    s += __shfl_xor(s, 1); s += __shfl_xor(s, 2); s += __shfl_xor(s, 4);
                    if (part == 0) qn_s[qi] = s; }
            }
#pragma unroll
            for (int rep = 0; rep < 2; ++rep) { const int id = tid + 512 * rep, d = id & 127, jg = id >> 7, j0 = jg * 8;
                float kv[8];
#pragma unroll
                for (int x = 0; x < 8; ++x) kv[x] = bf1(*(const LAS bf16_t*)(lds + SK + (j0 + x) * LQ + d * 2)) * __expf(a_s[p0 + j0 + x] - M_last);
                u32x4 o; o.x = cvt_pk_bf16(kv[0], kv[1]); o.y = cvt_pk_bf16(kv[2], kv[3]); o.z = cvt_pk_bf16(kv[4], kv[5]); o.w = cvt_pk_bf16(kv[6], kv[7]);
                *(LAS u32x4*)(lds + SKT + d * LV + j0 * 2) = o; }
            { const int e = tid & 63, jg = tid >> 6, j0 = jg * 8; unsigned vv[8];
#pragma unroll
                for (int x = 0; x < 8; ++x) vv[x] = *(const LAS bf16_t*)(lds + SV + (j0 + x) * LV + e * 2);
                u32x4 o; o.x = vv[0] | (vv[1] << 16); o.y = vv[2] | (vv[3] << 16); o.z = vv[4] | (vv[5] << 16); o.w = vv[6] | (vv[7] << 16);
                *(LAS u32x4*)(lds + SVT + e * LV + j0 * 2) = o; }
            __syncthreads();
            if (emit) {
#pragma unroll
                for (int kk = 0; kk < 2; ++kk) {
                    const bf16x8 bp = *(const LAS bf16x8*)(lds + SP + i_loc * LV + (kk * 32 + fq * 8) * 2);
#pragma unroll
                    for (int t2 = 0; t2 < 2; ++t2) {
                        const bf16x8 av = *(const LAS bf16x8*)(lds + SVT + ((sub * 2 + t2) * 16 + fr) * LV + (kk * 32 + fq * 8) * 2);
                        hacc[t2] = __builtin_amdgcn_mfma_f32_16x16x32_bf16(av, bp, hacc[t2], 0, 0, 0);
                    }
                }
                float den = rs_s[i_loc] + rs_s[64 + i_loc] + w_inter * qn_s[i_loc];
                den = fmaxf(fabsf(den), __expf(-(B_s[p0 + i_loc] + M_i)));
                const float rden = __builtin_amdgcn_rcpf(den);
                const size_t orow = (size_t)scan_row(p0 + i_loc, b, dir);
#pragma unroll
                for (int t2 = 0; t2 < 2; ++t2) { const int e0 = (sub * 2 + t2) * 16 + 4 * fq;
                    u32x2 o; o.x = cvt_pk_bf16(hacc[t2][0] * rden, hacc[t2][1] * rden); o.y = cvt_pk_bf16(hacc[t2][2] * rden, hacc[t2][3] * rden);
                    *(u32x2*)(Hout + orow * D + h * HD + dvh * 64 + e0) = o; }
            }
#pragma unroll
            for (int te = 0; te < 4; ++te) cacc[te] = cacc[te] * decay;
#pragma unroll
            for (int kk = 0; kk < 2; ++kk) {
                const bf16x8 ak = *(const LAS bf16x8*)(lds + SKT + (wave * 16 + fr) * LV + (kk * 32 + fq * 8) * 2);
#pragma unroll
                for (int te = 0; te < 4; ++te) {
                    const bf16x8 bv = *(const LAS bf16x8*)(lds + SVT + (te * 16 + fr) * LV + (kk * 32 + fq * 8) * 2);
                    cacc[te] = __builtin_amdgcn_mfma_f32_16x16x32_bf16(ak, bv, cacc[te], 0, 0, 0);
                }
            }
#pragma unroll
            for (int te = 0; te < 4; ++te) { u32x2 o; o.x = cvt_pk_bf16(cacc[te][0], cacc[te][1]); o.y = cvt_pk_bf16(cacc[te][2], cacc[te][3]);
                *(LAS u32x2*)(lds + SC + (te * 16 + fr) * LQ + (wave * 16 + 4 * fq) * 2) = o; }
            if (tid < 128) { float s = 0.f;
#pragma unroll
                for (int g8 = 0; g8 < 8; ++g8) { const u32x4 w = *(const LAS u32x4*)(lds + SKT + tid * LV + g8 * 16);
                    s += (bf_lo(w.x) + bf_hi(w.x)) + (bf_lo(w.y) + bf_hi(w.y)) + (bf_lo(w.z) + bf_hi(w.z)) + (bf_lo(w.w) + bf_hi(w.w)); }
                n_s[tid] = decay * n_s[tid] + s; }
        }
    }
    __syncthreads();
}

__device__ __forceinline__ void phase_mix(const Params& p, int G) {
    const int tid = opaque_tid(), lane = tid & 63, wave = tid >> 6;
    const int gw = blockIdx.x * 8 + wave, NGW = G * 8;
    const bf16_t* U = (const bf16_t*)(p.ws + WS_Q); bf16_t* BZ = (bf16_t*)(p.ws + WS_K); bf16_t* OZ = (bf16_t*)(p.ws + WS_V);
    const bf16_t* HF = (const bf16_t*)(p.ws + WS_HF); const bf16_t* HB = (const bf16_t*)(p.ws + WS_HB);
    const int c0 = lane * 16;
    const int per = (M_LAT + NGW - 1) / NGW;
    const int mbeg = gw * per, mend = min(mbeg + per, M_LAT);
    {
        f32x4 w0[4], w1[4], w2[4], bc[4];
#pragma unroll
        for (int j = 0; j < 4; ++j) { w0[j] = *(const f32x4*)(p.w_conv + c0 + 4 * j); w1[j] = *(const f32x4*)(p.w_conv + D + c0 + 4 * j); w2[j] = *(const f32x4*)(p.w_conv + 2 * D + c0 + 4 * j); bc[j] = *(const f32x4*)(p.b_conv + c0 + 4 * j); }
        for (int m = mbeg; m < mend; m += 4) {
            u32x4 ur[6][2], br[4][2];
#pragma unroll
            for (int q = 0; q < 6; ++q) { const int mm = min(max(m - 1 + q, 0), M_LAT - 1); ur[q][0] = *(const u32x4*)(U + (size_t)mm * D + c0); ur[q][1] = *(const u32x4*)(U + (size_t)mm * D + c0 + 8); }
#pragma unroll
            for (int q = 0; q < 4; ++q) { const int mm = min(m + q, mend - 1); br[q][0] = *(const u32x4*)(BZ + (size_t)mm * D + c0); br[q][1] = *(const u32x4*)(BZ + (size_t)mm * D + c0 + 8); }
#pragma unroll
            for (int q = 0; q < 4; ++q) { const int mm = m + q; if (mm >= mend) break;
                const int t = mm & 63;
                f32x4 um[4], uc[4], up[4], bz[4];
                unpack8(ur[q][0], um[0], um[1]); unpack8(ur[q][1], um[2], um[3]);
                unpack8(ur[q + 1][0], uc[0], uc[1]); unpack8(ur[q + 1][1], uc[2], uc[3]);
                unpack8(ur[q + 2][0], up[0], up[1]); unpack8(ur[q + 2][1], up[2], up[3]);
                unpack8(br[q][0], bz[0], bz[1]); unpack8(br[q][1], bz[2], bz[3]);
                const float fm = t != 0 ? 1.f : 0.f, fp = t != 63 ? 1.f : 0.f;
                f32x4 ya[4];
#pragma unroll
                for (int j = 0; j < 4; ++j) ya[j] = bz[j] * (w0[j] * (um[j] * fm) + w1[j] * uc[j] + w2[j] * (up[j] * fp) + bc[j]);
                *(u32x4*)(BZ + (size_t)mm * D + c0) = pack8(ya[0], ya[1]); *(u32x4*)(BZ + (size_t)mm * D + c0 + 8) = pack8(ya[2], ya[3]);
            }
        }
    }
    {
        f32x4 gh[4];
#pragma unroll
        for (int j = 0; j < 4; ++j) gh[j] = *(const f32x4*)(p.g_head + c0 + 4 * j);
        for (int m = mbeg; m < mend; m += 4) {
            u32x4 fr_[4][2], br_[4][2], zr[4][2];
#pragma unroll
            for (int q = 0; q < 4; ++q) { const size_t ro = (size_t)min(m + q, mend - 1) * D + c0;
                fr_[q][0] = *(const u32x4*)(HF + ro); fr_[q][1] = *(const u32x4*)(HF + ro + 8); br_[q][0] = *(const u32x4*)(HB + ro); br_[q][1] = *(const u32x4*)(HB + ro + 8);
                zr[q][0] = *(const u32x4*)(OZ + ro); zr[q][1] = *(const u32x4*)(OZ + ro + 8); }
#pragma unroll
            for (int q = 0; q < 4; ++q) { const int mm = m + q; if (mm >= mend) break;
                f32x4 hv[4], hb[4], oz[4];
                unpack8(fr_[q][0], hv[0], hv[1]); unpack8(fr_[q][1], hv[2], hv[3]); unpack8(br_[q][0], hb[0], hb[1]); unpack8(br_[q][1], hb[2], hb[3]);
                unpack8(zr[q][0], oz[0], oz[1]); unpack8(zr[q][1], oz[2], oz[3]);
                float ss = 0.f;
#pragma unroll
                for (int j = 0; j < 4; ++j) { hv[j] = hv[j] + hb[j]; ss += (hv[j][0] * hv[j][0] + hv[j][1] * hv[j][1]) + (hv[j][2] * hv[j][2] + hv[j][3] * hv[j][3]); }
                ss += __shfl_xor(ss, 1); ss += __shfl_xor(ss, 2); ss += __shfl_xor(ss, 4);
                const float rstd = rsqrtf(ss * (1.0f / HD) + EPS);
                f32x4 yb[4];
#pragma unroll
                for (int j = 0; j < 4; ++j) yb[j] = oz[j] * (hv[j] * rstd * gh[j]);
                *(u32x4*)(OZ + (size_t)mm * D + c0) = pack8(yb[0], yb[1]); *(u32x4*)(OZ + (size_t)mm * D + c0 + 8) = pack8(yb[2], yb[3]);
            }
        }
    }
}

__device__ __forceinline__ void phase_final(const Params& p, int G) {
    const int tid = opaque_tid(), lane = tid & 63, wave = tid >> 6;
    const int gw = blockIdx.x * 8 + wave, NGW = G * 8;
    f32x4 gf[4];
#pragma unroll
    for (int j = 0; j < 4; ++j) gf[j] = *(const f32x4*)(p.g_final + (lane + 64 * j) * 4);
    const int per = (M_LAT + NGW - 1) / NGW;
    const int mend = min((gw + 1) * per, M_LAT);
    for (int m = gw * per; m < mend; m += 4) {
        f32x4 v[4][4];
#pragma unroll
        for (int q = 0; q < 4; ++q) { const float* xr = p.out + (size_t)min(m + q, mend - 1) * D;
#pragma unroll
            for (int j = 0; j < 4; ++j) v[q][j] = *(const f32x4*)(xr + (lane + 64 * j) * 4); }
#pragma unroll
        for (int q = 0; q < 4; ++q) { if (m + q >= mend) break;
            float ss = 0.f;
#pragma unroll
            for (int j = 0; j < 4; ++j) ss += (v[q][j][0] * v[q][j][0] + v[q][j][1] * v[q][j][1]) + (v[q][j][2] * v[q][j][2] + v[q][j][3] * v[q][j][3]);
            const float rstd = rsqrtf(wave_sum(ss) * (1.0f / D) + EPS);
            float* xr = p.out + (size_t)(m + q) * D;
#pragma unroll
            for (int j = 0; j < 4; ++j) *(f32x4*)(xr + (lane + 64 * j) * 4) = v[q][j] * rstd * gf[j];
        }
    }
}

#define XB_TMO      128
#define XB_XCNT(j)  (256  + 64 * (j))
#define XB_XSUB(j)  (1280 + 64 * (j))
#define XB_XGEN(j)  (2304 + 64 * (j))
#define XB_TOP      3328
#define XB_TOPGEN   3392
#define XCD_BAR_WORDS 3456
#define XB_SPIN_CAP (1u << 18)
__device__ __forceinline__ unsigned xb_ld(unsigned* p)              { return __hip_atomic_load(p, __ATOMIC_RELAXED, __HIP_MEMORY_SCOPE_AGENT); }
__device__ __forceinline__ unsigned xb_add(unsigned* p, unsigned v) { return __hip_atomic_fetch_add(p, v, __ATOMIC_RELAXED, __HIP_MEMORY_SCOPE_AGENT); }
__device__ __forceinline__ unsigned xb_xcc_id() { return (unsigned)__builtin_amdgcn_s_getreg((3 << 11) | 20) & 0xFu; }
#define XB_SPIN(cond, bar) do { unsigned _sp = 0; while (cond) { __builtin_amdgcn_s_sleep(1); \
    if ((++_sp & 255u) == 0u) { if (xb_ld(&(bar)[XB_TMO])) break; if (_sp > XB_SPIN_CAP) { atomicAdd(&(bar)[XB_TMO], 1u); break; } } } } while (0)
struct XcdBarrier { unsigned* bar; unsigned x; volatile LAS unsigned* st; };
__device__ __forceinline__ XcdBarrier xcd_barrier_post(unsigned* bar, volatile LAS unsigned* st) {
    XcdBarrier b; b.bar = bar; b.x = xb_xcc_id(); b.st = st;
    if (threadIdx.x == 0) (void)xb_add(&bar[XB_XCNT(b.x)], 1u);
    return b;
}
__device__ __forceinline__ void xcd_barrier_complete(unsigned* bar, unsigned x, unsigned& nloc, unsigned& nx) {
    const unsigned G = gridDim.x * gridDim.y * gridDim.z;
    unsigned sum, cnt, mine, sp = 0u;
    for (;;) {
        sum = 0u; cnt = 0u; mine = 0u;
#pragma unroll
        for (unsigned j = 0; j < 16; ++j) { const unsigned c = xb_ld(&bar[XB_XCNT(j)]); sum += c; cnt += (c > 0u) ? 1u : 0u; mine = (j == x) ? c : mine; }
        if (sum == G) break;
        __builtin_amdgcn_s_sleep(1);
        if ((++sp & 255u) == 0u) { if (xb_ld(&bar[XB_TMO])) break; if (sp > XB_SPIN_CAP) { atomicAdd(&bar[XB_TMO], 1u); break; } }
    }
    nloc = mine > 0u ? mine : 1u; nx = cnt > 0u ? cnt : 1u;
}
__device__ __forceinline__ void xcd_barrier(const XcdBarrier& b) {
    asm volatile("s_waitcnt vmcnt(0)" ::: "memory");
    __syncthreads();
    if (threadIdx.x == 0) {
        unsigned* bar = b.bar;
        __builtin_amdgcn_s_waitcnt(0);
        unsigned nloc = b.st[0], nx = b.st[1];
        if (nloc == 0u) { xcd_barrier_complete(bar, b.x, nloc, nx); b.st[0] = nloc; b.st[1] = nx; }
        const unsigned old = xb_add(&bar[XB_XSUB(b.x)], 1u);
        const unsigned gen = old / nloc;
        if (old + 1u == (gen + 1u) * nloc) {
            __builtin_amdgcn_fence(__ATOMIC_RELEASE, "agent");
            asm volatile("s_waitcnt vmcnt(0)" ::: "memory");
            const unsigned og = xb_add(&bar[XB_TOP], 1u);
            const unsigned tg = og / nx;
            if (og + 1u == (tg + 1u) * nx) xb_add(&bar[XB_TOPGEN], 1u);
            else XB_SPIN(xb_ld(&bar[XB_TOPGEN]) == tg, bar);
            __builtin_amdgcn_fence(__ATOMIC_ACQUIRE, "agent");
            xb_add(&bar[XB_XGEN(b.x)], 1u);
            asm volatile("s_waitcnt vmcnt(0)" ::: "memory");
        } else {
            XB_SPIN(xb_ld(&bar[XB_XGEN(b.x)]) == gen, bar);
            __builtin_amdgcn_fence(__ATOMIC_ACQUIRE, "agent");
            asm volatile("s_waitcnt vmcnt(0)" ::: "memory");
        }
    }
    __syncthreads();
}

__global__ void __launch_bounds__(512, 2) fwd_megakernel(Params p) {
    extern __shared__ __attribute__((aligned(16))) unsigned char shm[];
    LAS unsigned char* lds = (LAS unsigned char*)shm;
    cg::grid_group grid = cg::this_grid();
    volatile LAS unsigned* bst = (volatile LAS unsigned*)(lds + LDS_STAGE);
    if (threadIdx.x < 2) bst[threadIdx.x] = 0u;
    __syncthreads();
    const XcdBarrier xbar = xcd_barrier_post((unsigned*)(p.ws + WS_BAR), bst);
    if (p.ws == nullptr) grid.sync();
#define GRID_SYNC() xcd_barrier(xbar)
#ifndef TIME_PHASE
#define TIME_PHASE -1
#endif
#define T_BEGIN(k) do { if (TIME_PHASE == (k) && threadIdx.x == 0) bst[4] = (unsigned)__builtin_amdgcn_s_memrealtime(); } while (0)
#define T_END(k) do { if (TIME_PHASE == (k) && threadIdx.x == 0) bst[5] = (unsigned)__builtin_amdgcn_s_memrealtime() - bst[4]; } while (0)
    const int G = gridDim.x;
    unsigned char* ws = p.ws;
    EpiPtrs E; E.ws = ws; E.out = p.out; E.x = p.x; E.bout = p.b_out;

    T_BEGIN(0); phase_prep(p, lds, G);
    GRID_SYNC(); T_END(0);
    T_BEGIN(1); phase_hx(p, G);
    GRID_SYNC(); T_END(1);
    T_BEGIN(2);
    {
        pg8::Gemm g{(const bf16_t*)(ws + WS_A0), (const bf16_t*)(ws + WS_WIN), M_ALL, N_STATE_PAD, D};
        pg8::StateOrder S; S.init(M_LAT, N_STATE_PAD, G, (int)blockIdx.x);
        Epi<0> e{E};
        pg8::gemm_phase(lds, g, S, e);
    }
    GRID_SYNC(); T_END(2);
    T_BEGIN(3); phase_scan(p, lds, G);
    GRID_SYNC(); T_END(3);
    T_BEGIN(4);
    {
        pg8::Gemm g{(const bf16_t*)(ws + WS_A0), (const bf16_t*)(ws + WS_WIN) + (size_t)N_STATE_PAD * D, M_LAT, N_REST, D};
        pg8::StaticOrder S; S.init(M_LAT, N_REST, G, (int)blockIdx.x);
        Epi<1> e{E};
        pg8::gemm_phase(lds, g, S, e);
    }
    GRID_SYNC(); T_END(4);
    T_BEGIN(5); phase_mix(p, G);
    GRID_SYNC(); T_END(5);
    T_BEGIN(6);
    {
        pg8::Gemm g{(const bf16_t*)(ws + WS_K), (const bf16_t*)(ws + WS_WPA), M_LAT, D, D};
        pg8::PairOrder S; S.init(M_LAT, D, G, (int)blockIdx.x);
        Epi<2> e{E};
        pg8::gemm_phase(lds, g, S, e);
    }
    GRID_SYNC(); T_END(6);
    T_BEGIN(7);
    {
        pg8::StaticOrder S; S.init(M_LAT, D, G, (int)blockIdx.x);
        pg8::Gemm g{(const bf16_t*)(ws + WS_A0), (const bf16_t*)(ws + WS_WOUT), M_LAT, D, D}; Epi<4> e{E}; pg8::gemm_phase(lds, g, S, e);
    }
    GRID_SYNC(); T_END(7);
    T_BEGIN(8); phase_final(p, G); T_END(8);
    if (TIME_PHASE >= 0 && blockIdx.x == 0 && threadIdx.x == 0) { const unsigned t0 = (unsigned)__builtin_amdgcn_s_memrealtime(), w = 8u * bst[5]; while ((unsigned)__builtin_amdgcn_s_memrealtime() - t0 < w) __builtin_amdgcn_s_sleep(8); }
}

extern "C" void kernel_launch(void* const* d_in, const int* in_sizes, int n_in, void* d_out, int out_size, void* d_ws, size_t ws_size, hipStream_t stream) {
    static int grid_blocks = 0;
    if (!grid_blocks) {
        int dev = 0, cus = 0, per_cu = 0;
        hipGetDevice(&dev);
        hipDeviceGetAttribute(&cus, hipDeviceAttributeMultiprocessorCount, dev);
        if (hipFuncSetAttribute((const void*)fwd_megakernel, hipFuncAttributeMaxDynamicSharedMemorySize, LDS_BYTES) != hipSuccess) fprintf(stderr, "kernel_launch: hipFuncSetAttribute failed\n");
        if (hipOccupancyMaxActiveBlocksPerMultiprocessor(&per_cu, (const void*)fwd_megakernel, 512, LDS_BYTES) != hipSuccess || per_cu < 1) { fprintf(stderr, "kernel_launch: occupancy query gave %d\n", per_cu); per_cu = 1; }
        grid_blocks = cus * per_cu;
        if (grid_blocks > 256) grid_blocks = 256;
        if (ws_size < WS_END) fprintf(stderr, "kernel_launch: workspace too small: %zu < %zu\n", ws_size, (size_t)WS_END);
    }
    Params p{};
    p.x = (const float*)d_in[0]; p.c = (const float*)d_in[1]; p.ctx = (const float*)d_in[2]; p.c_ctx = (const float*)d_in[3];
    p.w_ada = (const float*)d_in[4]; p.b_ada = (const float*)d_in[5]; p.g_norm = (const float*)d_in[6]; p.w_in = (const float*)d_in[7]; p.b_in = (const float*)d_in[8];
    p.w_conv = (const float*)d_in[9]; p.b_conv = (const float*)d_in[10]; p.g_head = (const float*)d_in[11]; p.w_pa = (const float*)d_in[12]; p.w_pb = (const float*)d_in[13];
    p.w_out = (const float*)d_in[14]; p.b_out = (const float*)d_in[15]; p.g_final = (const float*)d_in[16];
    p.out = (float*)d_out; p.ws = (unsigned char*)d_ws;
    (void)hipMemsetAsync((unsigned char*)d_ws + WS_BAR, 0, XCD_BAR_WORDS * 4, stream);
    void* args[] = {&p};
    hipError_t e = hipLaunchCooperativeKernel((const void*)fwd_megakernel, dim3(grid_blocks), dim3(512), args, LDS_BYTES, stream);
    if (e != hipSuccess) fprintf(stderr, "cooperative launch failed: %s (grid %d)\n", hipGetErrorString(e), grid_blocks);
}
```

```cpp
#include <hip/hip_runtime.h>
#include <hip/hip_cooperative_groups.h>
#include <cstdio>
#include <cstdint>
namespace cg = cooperative_groups;

#define LAS __attribute__((address_space(3)))
typedef unsigned short bf16_t;
typedef short bf16x8 __attribute__((ext_vector_type(8)));
typedef float f32x4 __attribute__((ext_vector_type(4)));
typedef unsigned u32x4 __attribute__((ext_vector_type(4)));
typedef unsigned u32x2 __attribute__((ext_vector_type(2)));

constexpr int D = 1024, NB = 8, SEQ = 2048, CTXL = 256, NH = 8, HD = 128;
constexpr int M_LAT = NB * SEQ, M_CTX = NB * CTXL, M_ALL = M_LAT + M_CTX;
constexpr int N_IN = 11296, N_PAD = 11520, N_STATE_PAD = 3328, N_REST = 8192;
constexpr int LSCAN = CTXL + SEQ;
constexpr float EPS = 1e-6f;
constexpr float QSCALE = 0.08838834764831845f;
constexpr int LDS_STAGE = 131072, LDS_BYTES = LDS_STAGE + 64;

constexpr size_t MiB = 1024 * 1024;
constexpr size_t WS_MOD = 0;
constexpr size_t WS_BIAS = 128 * 1024;
constexpr size_t WS_BAR = 176 * 1024;
constexpr size_t WS_GATES = 192 * 1024;
constexpr size_t WS_WIN = WS_GATES + (size_t)M_ALL * 32 * 4;
constexpr size_t WS_WPA = WS_WIN + (size_t)N_PAD * D * 2;
constexpr size_t WS_WPB = WS_WPA + 2 * MiB;
constexpr size_t WS_WOUT = WS_WPB + 2 * MiB;
constexpr size_t WS_A0 = WS_WOUT + 2 * MiB;
constexpr size_t WS_Q = WS_A0 + 36 * MiB;
constexpr size_t WS_K = WS_Q + 36 * MiB;
constexpr size_t WS_V = WS_K + 36 * MiB;
constexpr size_t WS_HF = WS_V + 36 * MiB;
constexpr size_t WS_HB = WS_HF + 32 * MiB;
constexpr size_t WS_END = WS_HB + 32 * MiB;

typedef __bf16 hbf16x2 __attribute__((ext_vector_type(2)));
typedef float f32x2v __attribute__((ext_vector_type(2)));
__device__ __forceinline__ unsigned cvt_pk_bf16(float lo, float hi) { const hbf16x2 r = __builtin_convertvector((f32x2v){lo, hi}, hbf16x2); return __builtin_bit_cast(unsigned, r); }
__device__ __forceinline__ float bf_lo(unsigned w) { return __uint_as_float(w << 16); }
__device__ __forceinline__ float bf_hi(unsigned w) { return __uint_as_float(w & 0xffff0000u); }
__device__ __forceinline__ float bf1(bf16_t b) { return __uint_as_float(((unsigned)b) << 16); }
__device__ __forceinline__ float fsigmoid(float x) { return __builtin_amdgcn_rcpf(1.0f + __expf(-x)); }
__device__ __forceinline__ float fsilu(float x) { return x * fsigmoid(x); }
__device__ __forceinline__ float wave_sum(float v) {
#pragma unroll
    for (int o = 1; o < 64; o <<= 1) v += __shfl_xor(v, o);
    return v;
}

namespace pg8 {
constexpr int BM = 256, BK = 64, HALF = 128, HTB = HALF * BK * 2, STAGE_BYTES = 8 * HTB, NXCD = 8, WGM = 8;
__host__ __device__ __forceinline__ int lds_byte(int r, int c) { const int st = (r >> 4) * 2 + (c >> 5), rr = r & 15, cc = c & 31, ob = rr * 64 + cc * 2; return st * 1024 + (ob ^ (((ob >> 9) & 1) << 5)); }
__host__ __device__ __forceinline__ void stage_rc(int b, int& R, int& C) { const int st = b / 1024, sb = b % 1024, swz = sb ^ (((sb >> 9) & 1) << 5); R = (st >> 1) * 16 + swz / 64; C = (st & 1) * 32 + (swz % 64) / 2; }
__host__ __device__ __forceinline__ int perm32(int rho) { const int n = rho >> 4, i = rho & 15; return 8 * (i >> 2) + 4 * n + (i & 3); }
struct Unit { int pm, pn; };
struct Gemm { const bf16_t* A; const bf16_t* Bt; int M, N, K; };
struct StaticOrder {
    int nM, nN, nwg, G, c;
    __host__ __device__ void init(int M, int N, int G_, int c_) { nM = M / BM; nN = N / BM; nwg = nM * nN; G = G_; c = c_; }
    __host__ __device__ bool map(long L, Unit& u) const {
        if (L >= nwg) return false;
        int wgid = (int)L; { const int q = nwg / NXCD, r = nwg % NXCD, xcd = wgid % NXCD, off = wgid / NXCD; wgid = (xcd < r ? xcd * (q + 1) : r * (q + 1) + (xcd - r) * q) + off; }
        const int nig = WGM * nN, gid = wgid / nig, fm = gid * WGM, gsz = (nM - fm) < WGM ? (nM - fm) : WGM;
        u.pm = fm + ((wgid % nig) % gsz); u.pn = (wgid % nig) / gsz; return true;
    }
    __host__ __device__ bool next(int i, Unit& u) const { return map((long)i * G + c, u); }
    __device__ __forceinline__ void a_ready(const Unit&) const {}
    __device__ __forceinline__ void done(const Unit&) const {}
};
struct StateOrder : StaticOrder {
    __host__ __device__ bool next(int i, Unit& u) const {
        const long L = (long)i * G + c;
        if (L < nwg) return map(L, u);
        const int idx = (int)(L - nwg); if (idx >= 72) return false;
        u.pm = 64 + (idx & 7); u.pn = 4 + (idx >> 3); return true;
    }
};

struct PairOrder : StaticOrder {
    __host__ __device__ bool next(int i, Unit& u) const {
        if (!map((long)(i >> 1) * G + c, u)) return false;
        if (i & 1) { u.pm += 72; u.pn += 4; }
        return true;
    }
};

template <class Epi, class Sched>
__device__ __forceinline__ void gemm_phase(LAS unsigned char* lds, const Gemm g, const Sched& S, const Epi& E) {
    int tid = threadIdx.x; asm volatile("" : "+v"(tid));
    const int wid = __builtin_amdgcn_readfirstlane(tid >> 6), lane = tid & 63, wr = wid >> 2, wc = wid & 3, fr = lane & 15, fq = lane >> 4;
    const int K = g.K, nt = K / BK;
    unsigned voffA[2], voffB[2];
#pragma unroll
    for (int i = 0; i < 2; ++i) { int R, C; stage_rc(tid * 16 + i * 8192, R, C); const int Rb = Epi::PERM ? ((R & ~31) + perm32(R & 31)) : R;
        voffA[i] = (unsigned)(R * K + C) * 2u; voffB[i] = (unsigned)(Rb * K + C) * 2u; }
    const size_t kstep = (size_t)(BK * 2);
    const size_t hstep = (size_t)HALF * K * 2;
    const size_t tstep = 2 * hstep;
    const unsigned ldsw = (unsigned)wid * 1024u;
    const int aoff = lds_byte(wr * 64 + fr, fq * 8), boff = lds_byte(wc * 32 + fr, fq * 8);
#define PG8_SA(b, h) (((b) * 2 + (h)) * HTB)
#define PG8_SB(b, h) ((4 + (b) * 2 + (h)) * HTB)
#define PG8_STAGE(bufoff, gbase, voff) do { _Pragma("unroll") for (int _i = 0; _i < 2; ++_i) \
        __builtin_amdgcn_global_load_lds((const unsigned*)((const char*)(gbase) + (voff)[_i]), (LAS unsigned*)(lds + (bufoff) + ldsw + _i * 8192), 16, 0, 0); } while (0)
#define PG8_LDA(dst, b, h) do { _Pragma("unroll") for (int m = 0; m < 4; ++m) _Pragma("unroll") for (int k = 0; k < 2; ++k) dst[m][k] = *(const LAS bf16x8*)(lds + PG8_SA(b, h) + aoff + m * 2048 + k * 1024); } while (0)
#define PG8_LDB(dst, b, h) do { _Pragma("unroll") for (int n = 0; n < 2; ++n) _Pragma("unroll") for (int k = 0; k < 2; ++k) dst[n][k] = *(const LAS bf16x8*)(lds + PG8_SB(b, h) + boff + n * 2048 + k * 1024); } while (0)
#define PG8_MMA(ai, bj, At, Bt) do { __builtin_amdgcn_s_setprio(1); _Pragma("unroll") for (int m = 0; m < 4; ++m) _Pragma("unroll") for (int n = 0; n < 2; ++n) _Pragma("unroll") for (int k = 0; k < 2; ++k) \
        acc[ai][bj][m][n] = __builtin_amdgcn_mfma_f32_16x16x32_bf16(Bt[n][k], At[m][k], acc[ai][bj][m][n], 0, 0, 0); __builtin_amdgcn_s_setprio(0); } while (0)
#define PG8_WAIT_V(n) asm volatile("s_waitcnt vmcnt(" #n ")" ::: "memory")
#define PG8_WAIT_L(n) asm volatile("s_waitcnt lgkmcnt(" #n ")" ::: "memory")
#define PG8_BAR __builtin_amdgcn_s_barrier()
#define PG8_SCHED __builtin_amdgcn_sched_barrier(0)
    Unit cur, nxt; int ui = 0;
    if (!S.next(0, cur)) return;
    f32x4 acc[2][2][4][2];
#pragma unroll
    for (int a = 0; a < 2; ++a)
#pragma unroll
        for (int b = 0; b < 2; ++b)
#pragma unroll
            for (int m = 0; m < 4; ++m)
#pragma unroll
                for (int n = 0; n < 2; ++n) acc[a][b][m][n] = (f32x4){0.f, 0.f, 0.f, 0.f};
    bf16x8 At[4][2], B0[2][2], B1[2][2];
    const char* cA = (const char*)g.A + (size_t)cur.pm * tstep; const char* cB = (const char*)g.Bt + (size_t)cur.pn * tstep;
    S.a_ready(cur);
    PG8_STAGE(PG8_SB(0, 0), cB, voffB); PG8_STAGE(PG8_SA(0, 0), cA, voffA); PG8_STAGE(PG8_SB(0, 1), cB + hstep, voffB); PG8_STAGE(PG8_SA(0, 1), cA + hstep, voffA);
    if (wr == 1) PG8_BAR;
    PG8_WAIT_V(4); PG8_BAR;
    PG8_STAGE(PG8_SB(1, 0), cB + kstep, voffB); PG8_STAGE(PG8_SA(1, 0), cA + kstep, voffA); PG8_STAGE(PG8_SB(1, 1), cB + hstep + kstep, voffB);
    PG8_WAIT_V(6); PG8_BAR;
    for (;;) {
        const bool has_next = S.next(ui + 1, nxt);
        const char* nA = has_next ? (const char*)g.A + (size_t)nxt.pm * tstep : cA; const char* nB = has_next ? (const char*)g.Bt + (size_t)nxt.pn * tstep : cB;
        for (int t = 0; t < nt; t += 2) {
            const bool last = (t == nt - 2);
            const char* a1 = cA + (size_t)(t + 1) * kstep;
            const char* a2 = last ? nA : cA + (size_t)(t + 2) * kstep; const char* b2 = last ? nB : cB + (size_t)(t + 2) * kstep;
            const char* a3 = a2 + kstep; const char* b3 = b2 + kstep;
            if (last && has_next) S.a_ready(nxt);
            PG8_LDB(B0, 0, 0); PG8_SCHED; PG8_LDA(At, 0, 0); PG8_STAGE(PG8_SA(1, 1), a1 + hstep, voffA);
            PG8_WAIT_L(8); PG8_BAR; PG8_WAIT_L(0); PG8_MMA(0, 0, At, B0); PG8_BAR; PG8_SCHED;
            PG8_LDB(B1, 0, 1); PG8_STAGE(PG8_SB(0, 0), b2, voffB);
            PG8_BAR; PG8_WAIT_L(0); PG8_MMA(0, 1, At, B1); PG8_BAR;
            PG8_LDA(At, 0, 1); PG8_STAGE(PG8_SA(0, 0), a2, voffA);
            PG8_BAR; PG8_WAIT_L(0); PG8_MMA(1, 0, At, B0); PG8_BAR; PG8_SCHED;
            PG8_STAGE(PG8_SB(0, 1), b2 + hstep, voffB);
            PG8_WAIT_V(6); PG8_BAR; PG8_MMA(1, 1, At, B1); PG8_BAR;
            PG8_LDB(B0, 1, 0); PG8_SCHED; PG8_LDA(At, 1, 0); PG8_STAGE(PG8_SA(0, 1), a2 + hstep, voffA);
            PG8_WAIT_L(8); PG8_BAR; PG8_WAIT_L(0); PG8_MMA(0, 0, At, B0); PG8_BAR; PG8_SCHED;
            PG8_LDB(B1, 1, 1); PG8_STAGE(PG8_SB(1, 0), b3, voffB);
            PG8_BAR; PG8_WAIT_L(0); PG8_MMA(0, 1, At, B1); PG8_BAR;
            PG8_LDA(At, 1, 1); PG8_STAGE(PG8_SA(1, 0), a3, voffA);
            PG8_BAR; PG8_WAIT_L(0); PG8_MMA(1, 0, At, B0); PG8_BAR; PG8_SCHED;
            PG8_STAGE(PG8_SB(1, 1), b3 + hstep, voffB);
            PG8_WAIT_V(6); PG8_BAR; PG8_MMA(1, 1, At, B1); PG8_BAR;
        }
        E(acc, cur, wr, wc, fr, fq); S.done(cur);
        if (!has_next) break;
        if (!E.keep(cur)) {
#pragma unroll
            for (int a = 0; a < 2; ++a)
#pragma unroll
                for (int b = 0; b < 2; ++b)
#pragma unroll
                    for (int m = 0; m < 4; ++m)
#pragma unroll
                        for (int n = 0; n < 2; ++n) acc[a][b][m][n] = (f32x4){0.f, 0.f, 0.f, 0.f};
        }
        cur = nxt; cA = nA; cB = nB; ++ui;
    }
    PG8_WAIT_V(0);
    if (wr == 0) PG8_BAR;
    PG8_BAR;
#undef PG8_SA
#undef PG8_SB
#undef PG8_STAGE
#undef PG8_LDA
#undef PG8_LDB
#undef PG8_MMA
#undef PG8_WAIT_V
#undef PG8_WAIT_L
#undef PG8_BAR
#undef PG8_SCHED
}
}

struct EpiPtrs { unsigned char* ws; float* out; const float* x; const float* bout; };
struct EpiView {
    bf16_t *Q, *K, *V, *U, *BZ, *OZ, *SGA, *SGB, *MERGED;
    float *GATES, *TMP, *OUT;
    const float *BIAS, *X, *MOD, *BOUT;
    __device__ __forceinline__ EpiView(const EpiPtrs& e) {
        unsigned char* ws = e.ws;
        Q = (bf16_t*)(ws + WS_Q); K = (bf16_t*)(ws + WS_K); V = (bf16_t*)(ws + WS_V); U = Q; BZ = K; OZ = V;
        SGA = (bf16_t*)e.out; SGB = (bf16_t*)e.out + (size_t)M_LAT * D; MERGED = (bf16_t*)(ws + WS_A0);
        GATES = (float*)(ws + WS_GATES); TMP = (float*)(ws + WS_HF); OUT = e.out;
        BIAS = (const float*)(ws + WS_BIAS); X = e.x; MOD = (const float*)(ws + WS_MOD); BOUT = e.bout;
    }
};
__device__ __forceinline__ u32x4 pack8(const f32x4 a, const f32x4 b) { u32x4 w; w.x = cvt_pk_bf16(a[0], a[1]); w.y = cvt_pk_bf16(a[2], a[3]); w.z = cvt_pk_bf16(b[0], b[1]); w.w = cvt_pk_bf16(b[2], b[3]); return w; }
__device__ __forceinline__ void unpack8(const u32x4 w, f32x4& a, f32x4& b) { a = (f32x4){bf_lo(w.x), bf_hi(w.x), bf_lo(w.y), bf_hi(w.y)}; b = (f32x4){bf_lo(w.z), bf_hi(w.z), bf_lo(w.w), bf_hi(w.w)}; }

template <int T> __device__ __forceinline__ void fused_pair(const f32x4 (&acc)[2][2][4][2], const f32x4 (&bv)[2][2], bf16_t* base) {
#pragma unroll
    for (int ai = 0; ai < 2; ++ai)
#pragma unroll
        for (int m = 0; m < 4; ++m) {
            f32x4 r[2];
#pragma unroll
            for (int n = 0; n < 2; ++n) {
                const f32x4 a = acc[ai][0][m][n] + bv[0][n], c = acc[ai][1][m][n] + bv[1][n];
#pragma unroll
                for (int x = 0; x < 4; ++x) {
                    if (T == 0) r[n][x] = a[x] * c[x];
                    else if (T == 1) r[n][x] = a[x] * c[x] * __builtin_amdgcn_rcpf(1.0f + __expf(-c[x]));
                    else r[n][x] = c[x] * __builtin_amdgcn_rcpf((1.0f + __expf(-a[x])) * (1.0f + __expf(-c[x])));
                }
            }
            *(u32x4*)(base + (size_t)(ai * 128 + m * 16) * D) = pack8(r[0], r[1]);
        }
}

template <int MODE> struct Epi {
    static constexpr bool PERM = true;
    EpiPtrs PP;
    __device__ __forceinline__ bool keep(const pg8::Unit& u) const { return MODE == 2 && u.pm < 72; }
    __device__ __forceinline__ void operator()(f32x4 (&acc)[2][2][4][2], const pg8::Unit& u, int wr, int wc, int fr, int fq) const {
        const EpiView P(PP);
        const int row0 = u.pm * 256 + wr * 64 + fr;
        const int lc = wc * 32 + 8 * fq;
        if constexpr (MODE == 0) {
            const int pn = u.pn;
            if (pn < 12) {
                bf16_t* base = pn < 4 ? P.Q : (pn < 8 ? P.K : P.V);
                const float sc = pn < 4 ? QSCALE : 1.0f;
                const int cb = (pn & 3) * 256 + lc;
#pragma unroll
                for (int bj = 0; bj < 2; ++bj) {
                    const f32x4 bv0 = *(const f32x4*)(P.BIAS + pn * 256 + bj * 128 + lc), bv1 = *(const f32x4*)(P.BIAS + pn * 256 + bj * 128 + lc + 4);
#pragma unroll
                    for (int ai = 0; ai < 2; ++ai)
#pragma unroll
                        for (int m = 0; m < 4; ++m) {
                            const f32x4 v0 = (acc[ai][bj][m][0] + bv0) * sc, v1 = (acc[ai][bj][m][1] + bv1) * sc;
                            *(u32x4*)(base + (size_t)(row0 + ai * 128 + m * 16) * D + cb + bj * 128) = pack8(v0, v1);
                        }
                }
            } else if (wc == 0) {
                const f32x4 b0 = *(const f32x4*)(P.BIAS + 3072 + 8 * fq), b1 = *(const f32x4*)(P.BIAS + 3072 + 8 * fq + 4);
#pragma unroll
                for (int ai = 0; ai < 2; ++ai)
#pragma unroll
                    for (int m = 0; m < 4; ++m) {
                        float* gp = P.GATES + (size_t)(row0 + ai * 128 + m * 16) * 32 + 8 * fq;
                        *(f32x4*)gp = acc[ai][0][m][0] + b0; *(f32x4*)(gp + 4) = acc[ai][0][m][1] + b1;
                    }
            }
        } else if constexpr (MODE == 1) {
            const int pn = u.pn;
            const float* bp = P.BIAS + N_STATE_PAD + pn * 256 + lc;
            f32x4 bv[2][2];
#pragma unroll
            for (int bj = 0; bj < 2; ++bj)
#pragma unroll
                for (int n = 0; n < 2; ++n) bv[bj][n] = *(const f32x4*)(bp + bj * 128 + 4 * n);
            if (pn < 24) {
                const int type = pn >> 3, k = pn & 7;
                bf16_t* base = (type == 0 ? P.U : (type == 1 ? P.BZ : P.OZ)) + (size_t)row0 * D + k * 128 + lc;
                if (type == 0) fused_pair<0>(acc, bv, base); else if (type == 1) fused_pair<1>(acc, bv, base); else fused_pair<2>(acc, bv, base);
            } else {
                bf16_t* base = pn < 28 ? P.SGA : P.SGB;
                const int cb = (pn & 3) * 256 + lc;
#pragma unroll
                for (int ai = 0; ai < 2; ++ai)
#pragma unroll
                    for (int m = 0; m < 4; ++m) {
                        bf16_t* rowp = base + (size_t)(row0 + ai * 128 + m * 16) * D + cb;
#pragma unroll
                        for (int bj = 0; bj < 2; ++bj) {
                            f32x4 r[2];
#pragma unroll
                            for (int n = 0; n < 2; ++n) { const f32x4 a = acc[ai][bj][m][n] + bv[bj][n];
#pragma unroll
                                for (int x = 0; x < 4; ++x) r[n][x] = fsigmoid(a[x]); }
                            *(u32x4*)(rowp + bj * 128) = pack8(r[0], r[1]);
                        }
                    }
            }
        } else if constexpr (MODE == 2) {
            if (u.pm < 72) {
                const int cb = u.pn * 256 + lc;
#pragma unroll
                for (int ai = 0; ai < 2; ++ai)
#pragma unroll
                    for (int m = 0; m < 4; ++m) {
                        const size_t ro = (size_t)(row0 + ai * 128 + m * 16) * D + cb;
#pragma unroll
                        for (int bj = 0; bj < 2; ++bj) {
                            f32x4 a0, a1, b0, b1; unpack8(*(const u32x4*)(P.SGA + ro + bj * 128), a0, a1); unpack8(*(const u32x4*)(P.SGB + ro + bj * 128), b0, b1);
#pragma unroll
                            for (int x = 0; x < 4; ++x) { acc[ai][bj][m][0][x] *= a0[x] * __builtin_amdgcn_rcpf(b0[x]); acc[ai][bj][m][1][x] *= a1[x] * __builtin_amdgcn_rcpf(b1[x]); }
                        }
                    }
            } else {
                const int cb = (u.pn - 4) * 256 + lc, r0 = row0 - 72 * 256;
#pragma unroll
                for (int ai = 0; ai < 2; ++ai)
#pragma unroll
                    for (int m = 0; m < 4; ++m) {
                        const size_t ro = (size_t)(r0 + ai * 128 + m * 16) * D + cb;
#pragma unroll
                        for (int bj = 0; bj < 2; ++bj) {
                            f32x4 g0, g1; unpack8(*(const u32x4*)(P.SGB + ro + bj * 128), g0, g1);
                            *(u32x4*)(P.MERGED + ro + bj * 128) = pack8(g0 * acc[ai][bj][m][0], g1 * acc[ai][bj][m][1]);
                        }
                    }
            }
        } else {
            const int cb = u.pn * 256 + lc;
            const int b = u.pm >> 3;
#pragma unroll
            for (int bj = 0; bj < 2; ++bj) {
                const f32x4 bo0 = *(const f32x4*)(P.BOUT + cb + bj * 128), bo1 = *(const f32x4*)(P.BOUT + cb + bj * 128 + 4);
                const f32x4 gt0 = *(const f32x4*)(P.MOD + b * 3072 + 2048 + cb + bj * 128), gt1 = *(const f32x4*)(P.MOD + b * 3072 + 2048 + cb + bj * 128 + 4);
#pragma unroll
                for (int ai = 0; ai < 2; ++ai) {
                    f32x4 xv[4][2];
#pragma unroll
                    for (int m = 0; m < 4; ++m) { const size_t ro = (size_t)(row0 + ai * 128 + m * 16) * D + cb + bj * 128;
                        xv[m][0] = *(const f32x4*)(P.X + ro); xv[m][1] = *(const f32x4*)(P.X + ro + 4); }
#pragma unroll
                    for (int m = 0; m < 4; ++m) { const size_t ro = (size_t)(row0 + ai * 128 + m * 16) * D + cb + bj * 128;
                        *(f32x4*)(P.OUT + ro) = xv[m][0] + gt0 * (acc[ai][bj][m][0] + bo0);
                        *(f32x4*)(P.OUT + ro + 4) = xv[m][1] + gt1 * (acc[ai][bj][m][1] + bo1); }
                }
            }
        }
    }
};

struct Params {
    const float *x, *c, *ctx, *c_ctx, *w_ada, *b_ada, *g_norm, *w_in, *b_in, *w_conv, *b_conv, *g_head, *w_pa, *w_pb, *w_out, *b_out, *g_final;
    float* out; unsigned char* ws;
};

__device__ __forceinline__ int src_col(int n) {
    if (n < 3104) return n;
    if (n < N_STATE_PAD) return -1;
    int r = n - N_STATE_PAD;
    if (r < 6144) {
        const int type = r >> 11, u = (r >> 8) & 7, half = (r >> 7) & 1, x = r & 127;
        int base;
        if (type == 0) base = half ? 7200 : 6176;
        else if (type == 1) base = half ? 8224 : 5152;
        else base = half ? 4128 : 3104;
        return base + 128 * u + x;
    }
    return 9248 + (r - 6144);
}
__device__ __forceinline__ void transpose_item(const float* W, int N, int ncol0  , bf16_t* WT, int row_dst, int k0, LAS float* scr, int lane) {
    if (ncol0 >= 0) {
#pragma unroll 8
        for (int i = 0; i < 32; ++i) { const int kk = 2 * i + (lane >> 5); scr[kk * 33 + (lane & 31)] = W[(size_t)(k0 + kk) * N + ncol0 + (lane & 31)]; }
    } else {
#pragma unroll 8
        for (int i = 0; i < 32; ++i) { const int kk = 2 * i + (lane >> 5); scr[kk * 33 + (lane & 31)] = 0.f; }
    }
    asm volatile("s_waitcnt vmcnt(0) lgkmcnt(0)" ::: "memory");
    const int cch = lane & 7;
#pragma unroll
    for (int j = 0; j < 4; ++j) { const int n = (lane >> 3) + 8 * j; const LAS float* s = scr + (8 * cch) * 33 + n;
        u32x4 o; o.x = cvt_pk_bf16(s[0 * 33], s[1 * 33]); o.y = cvt_pk_bf16(s[2 * 33], s[3 * 33]); o.z = cvt_pk_bf16(s[4 * 33], s[5 * 33]); o.w = cvt_pk_bf16(s[6 * 33], s[7 * 33]);
        *(u32x4*)(WT + (size_t)(row_dst + n) * D + k0 + 8 * cch) = o; }
    asm volatile("s_waitcnt lgkmcnt(0)" ::: "memory");
}

__device__ __forceinline__ int opaque_tid() { int t = threadIdx.x; asm volatile("" : "+v"(t)); return t; }
__device__ __forceinline__ void phase_prep(const Params& p, LAS unsigned char* lds, int G) {
    const int tid = opaque_tid(), lane = tid & 63, wave = tid >> 6;
    unsigned char* ws = p.ws;
    for (int task = blockIdx.x; task < 192; task += G) {
        LAS float* sc = (LAS float*)lds;
        LAS float* red = (LAS float*)(lds + 9 * 1024 * 4);
        {
            float cv[18];
#pragma unroll
            for (int q = 0; q < 18; ++q) { const int i = tid + 512 * q, r = i >> 10, k = i & 1023; cv[q] = r < 8 ? p.c[r * 1024 + k] : p.c_ctx[k]; }
#pragma unroll
            for (int q = 0; q < 18; ++q) sc[tid + 512 * q] = fsilu(cv[q]);
        }
        __syncthreads();
        const int nn = tid & 15, ks = tid >> 4, n0 = task * 16;
        float a[9];
#pragma unroll
        for (int r = 0; r < 9; ++r) a[r] = 0.f;
#pragma unroll
        for (int kb = 0; kb < 4; ++kb) {
            float w[8];
#pragma unroll
            for (int q = 0; q < 8; ++q) w[q] = p.w_ada[(size_t)(ks * 32 + kb * 8 + q) * 3072 + n0 + nn];
#pragma unroll
            for (int q = 0; q < 8; ++q)
#pragma unroll
                for (int r = 0; r < 9; ++r) a[r] += sc[r * 1024 + ks * 32 + kb * 8 + q] * w[q];
        }
#pragma unroll
        for (int r = 0; r < 9; ++r) red[(ks * 9 + r) * 16 + nn] = a[r];
        __syncthreads();
        if (tid < 144) { const int r = tid >> 4; float sum = p.b_ada[n0 + nn];
#pragma unroll
            for (int q = 0; q < 32; ++q) sum += red[(q * 9 + r) * 16 + nn];
            ((float*)(ws + WS_MOD))[r * 3072 + n0 + nn] = sum; }
        __syncthreads();
    }
    for (int i = blockIdx.x * 512 + tid; i < N_PAD; i += G * 512) { const int s = src_col(i); ((float*)(ws + WS_BIAS))[i] = s >= 0 ? p.b_in[s] : 0.f; }
    LAS float* scr = (LAS float*)(lds + wave * 8448);
    const int gw = blockIdx.x * 8 + wave, NGW = G * 8;
    constexpr int I_ST = 16 * (N_STATE_PAD / 32);
    for (int it = gw; it < I_ST; it += NGW) { const int nb = it >> 4, kb = it & 15; transpose_item(p.w_in, N_IN, src_col(nb * 32), (bf16_t*)(p.ws + WS_WIN), nb * 32, kb * 64, scr, lane); }
}
__device__ __forceinline__ void phase_prep_rest(const Params& p, LAS unsigned char* lds, int sidx, int nshort) {
    const int tid = opaque_tid(), lane = tid & 63, wave = tid >> 6;
    if (sidx < 0) return;
    LAS float* scr = (LAS float*)(lds + wave * 8448);
    const int gw = sidx * 8 + wave, NGW = nshort * 8;
    constexpr int I_REST = 16 * (N_REST / 32), I_SQ = 16 * 32;
    for (int it = gw; it < I_REST + 3 * I_SQ; it += NGW) {
        if (it < I_REST) { const int nb = (it >> 4) + N_STATE_PAD / 32, kb = it & 15; transpose_item(p.w_in, N_IN, src_col(nb * 32), (bf16_t*)(p.ws + WS_WIN), nb * 32, kb * 64, scr, lane); }
        else { int r = it - I_REST; const int which = r / I_SQ; r -= which * I_SQ; const int nb = r >> 4, kb = r & 15;
            const float* W = which == 0 ? p.w_pa : (which == 1 ? p.w_pb : p.w_out);
            bf16_t* WT = (bf16_t*)(p.ws + (which == 0 ? WS_WPA : (which == 1 ? WS_WPB : WS_WOUT)));
            transpose_item(W, D, nb * 32, WT, nb * 32, kb * 64, scr, lane); }
    }
}

__device__ __forceinline__ void phase_hx(const Params& p, int G) {
    const int tid = opaque_tid(), lane = tid & 63, wave = tid >> 6;
    const int gw = blockIdx.x * 8 + wave, NGW = G * 8;
    const float* MOD = (const float*)(p.ws + WS_MOD);
    bf16_t* A0 = (bf16_t*)(p.ws + WS_A0);
    const int per = (M_ALL + NGW - 1) / NGW;
    int curb = -1; f32x4 gs[4], sh[4];
    const int mend = min((gw + 1) * per, M_ALL);
    for (int m = gw * per; m < mend; m += 9) {
        f32x4 v[9][4];
#pragma unroll
        for (int q = 0; q < 9; ++q) { const int mm = min(m + q, mend - 1);
            const float* xr = mm < M_LAT ? p.x + (size_t)mm * D : p.ctx + (size_t)(mm - M_LAT) * D;
#pragma unroll
            for (int j = 0; j < 4; ++j) v[q][j] = *(const f32x4*)(xr + (lane + 64 * j) * 4); }
#pragma unroll
        for (int q = 0; q < 9; ++q) { const int mm = m + q; if (mm < mend) {
            const int b = mm < M_LAT ? (mm >> 11) : 8;
            if (b != curb) { curb = b;
#pragma unroll
                for (int j = 0; j < 4; ++j) { const int cidx = (lane + 64 * j) * 4;
                    const f32x4 g = *(const f32x4*)(p.g_norm + cidx), sv = *(const f32x4*)(MOD + b * 3072 + 1024 + cidx); sh[j] = *(const f32x4*)(MOD + b * 3072 + cidx); gs[j] = g * (sv + 1.0f); } }
            float ss = 0.f;
#pragma unroll
            for (int j = 0; j < 4; ++j) ss += (v[q][j][0] * v[q][j][0] + v[q][j][1] * v[q][j][1]) + (v[q][j][2] * v[q][j][2] + v[q][j][3] * v[q][j][3]);
            const float rstd = rsqrtf(wave_sum(ss) * (1.0f / D) + EPS);
#pragma unroll
            for (int j = 0; j < 4; ++j) { const f32x4 y = v[q][j] * rstd * gs[j] + sh[j];
                u32x2 o; o.x = cvt_pk_bf16(y[0], y[1]); o.y = cvt_pk_bf16(y[2], y[3]);
                *(u32x2*)(A0 + (size_t)mm * D + (lane + 64 * j) * 4) = o; }
        } }
    }
}

constexpr int SQ = 0, SK = 17408, SV = 34816, SKT = 44032, SVT = 62464, SC = 71680, SP = 89088, SA_ = 98304, SM_ = 107520, SB_ = 116736, SN = 125952, SQN = 126464, SRS = 126720;
constexpr int LQ = 272, LV = 144;

template <bool MAXOP> __device__ __forceinline__ float block_excl_scan256(float v, LAS float* buf, int t, float ident) {
    int cur = 0; if (t < 256) buf[t] = v; __syncthreads();
    for (int off = 1; off < 256; off <<= 1) {
        if (t < 256) { float x = buf[cur * 256 + t]; if (t >= off) { const float y = buf[cur * 256 + t - off]; x = MAXOP ? fmaxf(x, y) : x + y; } buf[(cur ^ 1) * 256 + t] = x; }
        __syncthreads(); cur ^= 1;
    }
    const float ex = (t < 256 && t > 0) ? buf[cur * 256 + t - 1] : ident;
    __syncthreads();
    return ex;
}

__device__ __forceinline__ int scan_row(int p, int b, int dir) {
    if (p < CTXL) return M_LAT + b * CTXL + (dir ? CTXL - 1 - p : p);
    const int q = p - CTXL; return b * SEQ + (dir ? SEQ - 1 - q : q);
}

__device__ __forceinline__ void phase_scan(const Params& p, LAS unsigned char* lds, int G) {
    const int tid = opaque_tid(), lane = tid & 63, wave = __builtin_amdgcn_readfirstlane(tid >> 6), fr = lane & 15, fq = lane >> 4;
    const bf16_t* Qg = (const bf16_t*)(p.ws + WS_Q); const bf16_t* Kg = (const bf16_t*)(p.ws + WS_K); const bf16_t* Vg = (const bf16_t*)(p.ws + WS_V);
    const float* GATES = (const float*)(p.ws + WS_GATES);
    LAS float* a_s = (LAS float*)(lds + SA_); LAS float* M_s = (LAS float*)(lds + SM_); LAS float* B_s = (LAS float*)(lds + SB_);
    LAS float* n_s = (LAS float*)(lds + SN); LAS float* qn_s = (LAS float*)(lds + SQN); LAS float* rs_s = (LAS float*)(lds + SRS);
    for (int item = blockIdx.x; item < 256; item += G) {
        const int dvh = item & 1, dir = (item >> 1) & 1, h = (item >> 2) & 7, b = item >> 5;
        bf16_t* Hout = (bf16_t*)(p.ws + (dir ? WS_HB : WS_HF));
        __syncthreads();
        {
            LAS float* buf = (LAS float*)(lds + SQ);
            float iv[9], lf[9]; float run = 0.f;
            if (tid < 256) {
#pragma unroll
                for (int e = 0; e < 9; ++e) { const int row = scan_row(tid * 9 + e, b, dir); const float* gp = GATES + (size_t)row * 32 + dir * 16 + h;
                    iv[e] = gp[0]; const float f = gp[8]; const float l = fminf(f, 0.f) - log1pf(__expf(-fabsf(f))); run += l; lf[e] = run; }
            }
            const float off = block_excl_scan256<false>(run, buf, tid, 0.f);
            float mx = -3.0e38f;
            if (tid < 256) {
#pragma unroll
                for (int e = 0; e < 9; ++e) { lf[e] += off; iv[e] -= lf[e]; mx = fmaxf(mx, iv[e]); }
            }
            const float moff = block_excl_scan256<true>(mx, buf, tid, 0.f);
            if (tid < 256) { float mr = fmaxf(moff, 0.f);
#pragma unroll
                for (int e = 0; e < 9; ++e) { const int pp = tid * 9 + e; mr = fmaxf(mr, iv[e]); a_s[pp] = iv[e]; M_s[pp] = mr; B_s[pp] = lf[e]; } }
            if (tid < 128) n_s[tid] = 0.f;
            for (int i = tid; i < 17408 / 16; i += 512) *(LAS u32x4*)(lds + SC + i * 16) = (u32x4){0u, 0u, 0u, 0u};
        }
        __syncthreads();
        f32x4 cacc[4];
#pragma unroll
        for (int te = 0; te < 4; ++te) cacc[te] = (f32x4){0.f, 0.f, 0.f, 0.f};
        u32x4 rq[2], rk[2], rv;
        const int colqk = h * HD + (tid & 15) * 8, colv = h * HD + dvh * 64 + (tid & 7) * 8;
#define ISSUE_LOADS(P0, EMIT) do { \
            _Pragma("unroll") for (int rep = 0; rep < 2; ++rep) { const size_t row = (size_t)scan_row((P0) + (tid >> 4) + 32 * rep, b, dir); \
                rk[rep] = *(const u32x4*)(Kg + row * D + colqk); \
                if (EMIT) rq[rep] = *(const u32x4*)(Qg + row * D + colqk); } \
            { const size_t row = (size_t)scan_row((P0) + (tid >> 3), b, dir); rv = *(const u32x4*)(Vg + row * D + colv); } } while (0)
        rq[0] = rq[1] = (u32x4){0u, 0u, 0u, 0u};
        ISSUE_LOADS(0, false);
        const int it = wave >> 1, sub = wave & 1;
        for (int ch = 0; ch < LSCAN / 64; ++ch) {
            const int p0 = ch * 64; const bool emit = p0 >= CTXL;
            __syncthreads();
#pragma unroll
            for (int rep = 0; rep < 2; ++rep) { const int r = (tid >> 4) + 32 * rep;
                *(LAS u32x4*)(lds + SK + r * LQ + (tid & 15) * 16) = rk[rep];
                if (emit) *(LAS u32x4*)(lds + SQ + r * LQ + (tid & 15) * 16) = rq[rep]; }
            *(LAS u32x4*)(lds + SV + (tid >> 3) * LV + (tid & 7) * 16) = rv;
            __syncthreads();
            if (ch + 1 < LSCAN / 64) ISSUE_LOADS(p0 + 64, (p0 + 64 >= CTXL));
            const float M_start = p0 > 0 ? M_s[p0 - 1] : 0.f, M_last = M_s[p0 + 63];
            const float decay = __expf(M_start - M_last);
            f32x4 hacc[2]; hacc[0] = (f32x4){0.f, 0.f, 0.f, 0.f}; hacc[1] = hacc[0];
            const int i_loc = it * 16 + fr;
            float M_i = 0.f, w_inter = 0.f;
            if (emit) {
                M_i = M_s[p0 + i_loc]; w_inter = __expf(M_start - M_i);
                f32x4 sacc[2]; sacc[0] = (f32x4){0.f, 0.f, 0.f, 0.f}; sacc[1] = sacc[0];
#pragma unroll
                for (int kk = 0; kk < 4; ++kk) {
                    const bf16x8 bq = *(const LAS bf16x8*)(lds + SQ + i_loc * LQ + (kk * 32 + fq * 8) * 2);
#pragma unroll
                    for (int t2 = 0; t2 < 2; ++t2) {
                        const bf16x8 ak = *(const LAS bf16x8*)(lds + SK + ((sub * 2 + t2) * 16 + fr) * LQ + (kk * 32 + fq * 8) * 2);
                        sacc[t2] = __builtin_amdgcn_mfma_f32_16x16x32_bf16(ak, bq, sacc[t2], 0, 0, 0);
                        const bf16x8 ac = *(const LAS bf16x8*)(lds + SC + ((sub * 2 + t2) * 16 + fr) * LQ + (kk * 32 + fq * 8) * 2);
                        hacc[t2] = __builtin_amdgcn_mfma_f32_16x16x32_bf16(ac, bq, hacc[t2], 0, 0, 0);
                    }
                }
                float rs = 0.f;
#pragma unroll
                for (int t2 = 0; t2 < 2; ++t2) {
                    const int j0 = (sub * 2 + t2) * 16 + 4 * fq;
                    const f32x4 av = *(const LAS f32x4*)(a_s + p0 + j0);
                    float pv[4];
#pragma unroll
                    for (int r = 0; r < 4; ++r) { const float e = (j0 + r <= i_loc) ? __expf(av[r] - M_i) : 0.f; pv[r] = sacc[t2][r] * e; rs += pv[r]; }
                    u32x2 o; o.x = cvt_pk_bf16(pv[0], pv[1]); o.y = cvt_pk_bf16(pv[2], pv[3]);
                    *(LAS u32x2*)(lds + SP + i_loc * LV + j0 * 2) = o;
                    hacc[t2] = hacc[t2] * w_inter;
                }
                rs += __shfl_xor(rs, 16); rs += __shfl_xor(rs, 32);
                if (fq == 0) rs_s[sub * 64 + i_loc] = rs;
                { const int qi = tid >> 3, part = tid & 7;
                    const u32x4 q0 = *(const LAS u32x4*)(lds + SQ + qi * LQ + part * 32), q1 = *(const LAS u32x4*)(lds + SQ + qi * LQ + part * 32 + 16);
                    const LAS float* np = n_s + part * 16;
                    float s = bf_lo(q0.x) * np[0] + bf_hi(q0.x) * np[1] + bf_lo(q0.y) * np[2] + bf_hi(q0.y) * np[3] + bf_lo(q0.z) * np[4] + bf_hi(q0.z) * np[5] + bf_lo(q0.w) * np[6] + bf_hi(q0.w) * np[7]
                            + bf_lo(q1.x) * np[8] + bf_hi(q1.x) * np[9] + bf_lo(q1.y) * np[10] + bf_hi(q1.y) * np[11] + bf_lo(q1.z) * np[12] + bf_hi(q1.z) * np[13] + bf_lo(q1.w) * np[14] + bf_hi(q1.w) * np[15];
                    s += __shfl_xor(s, 1); s += __shfl_xor(s, 2); s += __shfl_xor(s, 4);
                    if (part == 0) qn_s[qi] = s; }
            }
#pragma unroll
            for (int rep = 0; rep < 2; ++rep) { const int id = tid + 512 * rep, d = id & 127, jg = id >> 7, j0 = jg * 8;
                float kv[8];
#pragma unroll
                for (int x = 0; x < 8; ++x) kv[x] = bf1(*(const LAS bf16_t*)(lds + SK + (j0 + x) * LQ + d * 2)) * __expf(a_s[p0 + j0 + x] - M_last);
                u32x4 o; o.x = cvt_pk_bf16(kv[0], kv[1]); o.y = cvt_pk_bf16(kv[2], kv[3]); o.z = cvt_pk_bf16(kv[4], kv[5]); o.w = cvt_pk_bf16(kv[6], kv[7]);
                *(LAS u32x4*)(lds + SKT + d * LV + j0 * 2) = o; }
            { const int e = tid & 63, jg = tid >> 6, j0 = jg * 8; unsigned vv[8];
#pragma unroll
                for (int x = 0; x < 8; ++x) vv[x] = *(const LAS bf16_t*)(lds + SV + (j0 + x) * LV + e * 2);
                u32x4 o; o.x = vv[0] | (vv[1] << 16); o.y = vv[2] | (vv[3] << 16); o.z = vv[4] | (vv[5] << 16); o.w = vv[6] | (vv[7] << 16);
                *(LAS u32x4*)(lds + SVT + e * LV + j0 * 2) = o; }
            __syncthreads();
            if (emit) {
#pragma unroll
                for (int kk = 0; kk < 2; ++kk) {
                    const bf16x8 bp = *(const LAS bf16x8*)(lds + SP + i_loc * LV + (kk * 32 + fq * 8) * 2);
#pragma unroll
                    for (int t2 = 0; t2 < 2; ++t2) {
                        const bf16x8 av = *(const LAS bf16x8*)(lds + SVT + ((sub * 2 + t2) * 16 + fr) * LV + (kk * 32 + fq * 8) * 2);
                        hacc[t2] = __builtin_amdgcn_mfma_f32_16x16x32_bf16(av, bp, hacc[t2], 0, 0, 0);
                    }
                }
                float den = rs_s[i_loc] + rs_s[64 + i_loc] + w_inter * qn_s[i_loc];
                den = fmaxf(fabsf(den), __expf(-(B_s[p0 + i_loc] + M_i)));
                const float rden = __builtin_amdgcn_rcpf(den);
                const size_t orow = (size_t)scan_row(p0 + i_loc, b, dir);
#pragma unroll
                for (int t2 = 0; t2 < 2; ++t2) { const int e0 = (sub * 2 + t2) * 16 + 4 * fq;
                    u32x2 o; o.x = cvt_pk_bf16(hacc[t2][0] * rden, hacc[t2][1] * rden); o.y = cvt_pk_bf16(hacc[t2][2] * rden, hacc[t2][3] * rden);
                    *(u32x2*)(Hout + orow * D + h * HD + dvh * 64 + e0) = o; }
            }
#pragma unroll
            for (int te = 0; te < 4; ++te) cacc[te] = cacc[te] * decay;
#pragma unroll
            for (int kk = 0; kk < 2; ++kk) {
                const bf16x8 ak = *(const LAS bf16x8*)(lds + SKT + (wave * 16 + fr) * LV + (kk * 32 + fq * 8) * 2);
#pragma unroll
                for (int te = 0; te < 4; ++te) {
                    const bf16x8 bv = *(const LAS bf16x8*)(lds + SVT + (te * 16 + fr) * LV + (kk * 32 + fq * 8) * 2);
                    cacc[te] = __builtin_amdgcn_mfma_f32_16x16x32_bf16(ak, bv, cacc[te], 0, 0, 0);
                }
            }
#pragma unroll
            for (int te = 0; te < 4; ++te) { u32x2 o; o.x = cvt_pk_bf16(cacc[te][0], cacc[te][1]); o.y = cvt_pk_bf16(cacc[te][2], cacc[te][3]);
                *(LAS u32x2*)(lds + SC + (te * 16 + fr) * LQ + (wave * 16 + 4 * fq) * 2) = o; }
            if (tid < 128) { float s = 0.f;
#pragma unroll
                for (int g8 = 0; g8 < 8; ++g8) { const u32x4 w = *(const LAS u32x4*)(lds + SKT + tid * LV + g8 * 16);
                    s += (bf_lo(w.x) + bf_hi(w.x)) + (bf_lo(w.y) + bf_hi(w.y)) + (bf_lo(w.z) + bf_hi(w.z)) + (bf_lo(w.w) + bf_hi(w.w)); }
                n_s[tid] = decay * n_s[tid] + s; }
        }
    }
    __syncthreads();
}

__device__ __forceinline__ void phase_mix(const Params& p, int G) {
    const int tid = opaque_tid(), lane = tid & 63, wave = tid >> 6;
    const int gw = blockIdx.x * 8 + wave, NGW = G * 8;
    const bf16_t* U = (const bf16_t*)(p.ws + WS_Q); bf16_t* BZ = (bf16_t*)(p.ws + WS_K); bf16_t* OZ = (bf16_t*)(p.ws + WS_V);
    const bf16_t* HF = (const bf16_t*)(p.ws + WS_HF); const bf16_t* HB = (const bf16_t*)(p.ws + WS_HB);
    const int c0 = lane * 16;
    const int per = (M_LAT + NGW - 1) / NGW;
    const int mbeg = gw * per, mend = min(mbeg + per, M_LAT);
    {
        f32x4 w0[4], w1[4], w2[4], bc[4];
#pragma unroll
        for (int j = 0; j < 4; ++j) { w0[j] = *(const f32x4*)(p.w_conv + c0 + 4 * j); w1[j] = *(const f32x4*)(p.w_conv + D + c0 + 4 * j); w2[j] = *(const f32x4*)(p.w_conv + 2 * D + c0 + 4 * j); bc[j] = *(const f32x4*)(p.b_conv + c0 + 4 * j); }
        for (int m = mbeg; m < mend; m += 4) {
            u32x4 ur[6][2], br[4][2];
#pragma unroll
            for (int q = 0; q < 6; ++q) { const int mm = min(max(m - 1 + q, 0), M_LAT - 1); ur[q][0] = *(const u32x4*)(U + (size_t)mm * D + c0); ur[q][1] = *(const u32x4*)(U + (size_t)mm * D + c0 + 8); }
#pragma unroll
            for (int q = 0; q < 4; ++q) { const int mm = min(m + q, mend - 1); br[q][0] = *(const u32x4*)(BZ + (size_t)mm * D + c0); br[q][1] = *(const u32x4*)(BZ + (size_t)mm * D + c0 + 8); }
#pragma unroll
            for (int q = 0; q < 4; ++q) { const int mm = m + q; if (mm >= mend) break;
                const int t = mm & 63;
                f32x4 um[4], uc[4], up[4], bz[4];
                unpack8(ur[q][0], um[0], um[1]); unpack8(ur[q][1], um[2], um[3]);
                unpack8(ur[q + 1][0], uc[0], uc[1]); unpack8(ur[q + 1][1], uc[2], uc[3]);
                unpack8(ur[q + 2][0], up[0], up[1]); unpack8(ur[q + 2][1], up[2], up[3]);
                unpack8(br[q][0], bz[0], bz[1]); unpack8(br[q][1], bz[2], bz[3]);
                const float fm = t != 0 ? 1.f : 0.f, fp = t != 63 ? 1.f : 0.f;
                f32x4 ya[4];
#pragma unroll
                for (int j = 0; j < 4; ++j) ya[j] = bz[j] * (w0[j] * (um[j] * fm) + w1[j] * uc[j] + w2[j] * (up[j] * fp) + bc[j]);
                *(u32x4*)(BZ + (size_t)mm * D + c0) = pack8(ya[0], ya[1]); *(u32x4*)(BZ + (size_t)mm * D + c0 + 8) = pack8(ya[2], ya[3]);
            }
        }
    }
    {
        f32x4 gh[4];
#pragma unroll
        for (int j = 0; j < 4; ++j) gh[j] = *(const f32x4*)(p.g_head + c0 + 4 * j);
        for (int m = mbeg; m < mend; m += 4) {
            u32x4 fr_[4][2], br_[4][2], zr[4][2];
#pragma unroll
            for (int q = 0; q < 4; ++q) { const size_t ro = (size_t)min(m + q, mend - 1) * D + c0;
                fr_[q][0] = *(const u32x4*)(HF + ro); fr_[q][1] = *(const u32x4*)(HF + ro + 8); br_[q][0] = *(const u32x4*)(HB + ro); br_[q][1] = *(const u32x4*)(HB + ro + 8);
                zr[q][0] = *(const u32x4*)(OZ + ro); zr[q][1] = *(const u32x4*)(OZ + ro + 8); }
#pragma unroll
            for (int q = 0; q < 4; ++q) { const int mm = m + q; if (mm >= mend) break;
                f32x4 hv[4], hb[4], oz[4];
                unpack8(fr_[q][0], hv[0], hv[1]); unpack8(fr_[q][1], hv[2], hv[3]); unpack8(br_[q][0], hb[0], hb[1]); unpack8(br_[q][1], hb[2], hb[3]);
                unpack8(zr[q][0], oz[0], oz[1]); unpack8(zr[q][1], oz[2], oz[3]);
                float ss = 0.f;
#pragma unroll
                for (int j = 0; j < 4; ++j) { hv[j] = hv[j] + hb[j]; ss += (hv[j][0] * hv[j][0] + hv[j][1] * hv[j][1]) + (hv[j][2] * hv[j][2] + hv[j][3] * hv[j][3]); }
                ss += __shfl_xor(ss, 1); ss += __shfl_xor(ss, 2); ss += __shfl_xor(ss, 4);
                const float rstd = rsqrtf(ss * (1.0f / HD) + EPS);
                f32x4 yb[4];
#pragma unroll
                for (int j = 0; j < 4; ++j) yb[j] = oz[j] * (hv[j] * rstd * gh[j]);
                *(u32x4*)(OZ + (size_t)mm * D + c0) = pack8(yb[0], yb[1]); *(u32x4*)(OZ + (size_t)mm * D + c0 + 8) = pack8(yb[2], yb[3]);
            }
        }
    }
}

__device__ __forceinline__ void phase_final(const Params& p, int G) {
    const int tid = opaque_tid(), lane = tid & 63, wave = tid >> 6;
    const int gw = blockIdx.x * 8 + wave, NGW = G * 8;
    f32x4 gf[4];
#pragma unroll
    for (int j = 0; j < 4; ++j) gf[j] = *(const f32x4*)(p.g_final + (lane + 64 * j) * 4);
    const int per = (M_LAT + NGW - 1) / NGW;
    const int mend = min((gw + 1) * per, M_LAT);
    for (int m = gw * per; m < mend; m += 4) {
        f32x4 v[4][4];
#pragma unroll
        for (int q = 0; q < 4; ++q) { const float* xr = p.out + (size_t)min(m + q, mend - 1) * D;
#pragma unroll
            for (int j = 0; j < 4; ++j) v[q][j] = *(const f32x4*)(xr + (lane + 64 * j) * 4); }
#pragma unroll
        for (int q = 0; q < 4; ++q) { if (m + q >= mend) break;
            float ss = 0.f;
#pragma unroll
            for (int j = 0; j < 4; ++j) ss += (v[q][j][0] * v[q][j][0] + v[q][j][1] * v[q][j][1]) + (v[q][j][2] * v[q][j][2] + v[q][j][3] * v[q][j][3]);
            const float rstd = rsqrtf(wave_sum(ss) * (1.0f / D) + EPS);
            float* xr = p.out + (size_t)(m + q) * D;
#pragma unroll
            for (int j = 0; j < 4; ++j) *(f32x4*)(xr + (lane + 64 * j) * 4) = v[q][j] * rstd * gf[j];
        }
    }
}

#define XB_TMO      128
#define XB_XCNT(j)  (256  + 64 * (j))
#define XB_XSUB(j)  (1280 + 64 * (j))
#define XB_XGEN(j)  (2304 + 64 * (j))
#define XB_TOP      3328
#define XB_TOPGEN   3392
#define XCD_BAR_WORDS 3456
#define XB_SPIN_CAP (1u << 18)
__device__ __forceinline__ unsigned xb_ld(unsigned* p)              { return __hip_atomic_load(p, __ATOMIC_RELAXED, __HIP_MEMORY_SCOPE_AGENT); }
__device__ __forceinline__ unsigned xb_add(unsigned* p, unsigned v) { return __hip_atomic_fetch_add(p, v, __ATOMIC_RELAXED, __HIP_MEMORY_SCOPE_AGENT); }
__device__ __forceinline__ unsigned xb_xcc_id() { return (unsigned)__builtin_amdgcn_s_getreg((3 << 11) | 20) & 0xFu; }
#define XB_SPIN(cond, bar) do { unsigned _sp = 0; while (cond) { __builtin_amdgcn_s_sleep(1); \
    if ((++_sp & 255u) == 0u) { if (xb_ld(&(bar)[XB_TMO])) break; if (_sp > XB_SPIN_CAP) { atomicAdd(&(bar)[XB_TMO], 1u); break; } } } } while (0)
struct XcdBarrier { unsigned* bar; unsigned x; volatile LAS unsigned* st; };
__device__ __forceinline__ XcdBarrier xcd_barrier_post(unsigned* bar, volatile LAS unsigned* st) {
    XcdBarrier b; b.bar = bar; b.x = xb_xcc_id(); b.st = st;
    if (threadIdx.x == 0) (void)xb_add(&bar[XB_XCNT(b.x)], 1u);
    return b;
}
__device__ __forceinline__ void xcd_barrier_complete(unsigned* bar, unsigned x, unsigned& nloc, unsigned& nx) {
    const unsigned G = gridDim.x * gridDim.y * gridDim.z;
    unsigned sum, cnt, mine, sp = 0u;
    for (;;) {
        sum = 0u; cnt = 0u; mine = 0u;
#pragma unroll
        for (unsigned j = 0; j < 16; ++j) { const unsigned c = xb_ld(&bar[XB_XCNT(j)]); sum += c; cnt += (c > 0u) ? 1u : 0u; mine = (j == x) ? c : mine; }
        if (sum == G) break;
        __builtin_amdgcn_s_sleep(1);
        if ((++sp & 255u) == 0u) { if (xb_ld(&bar[XB_TMO])) break; if (sp > XB_SPIN_CAP) { atomicAdd(&bar[XB_TMO], 1u); break; } }
    }
    nloc = mine > 0u ? mine : 1u; nx = cnt > 0u ? cnt : 1u;
}
__device__ __forceinline__ void xcd_barrier(const XcdBarrier& b) {
    asm volatile("s_waitcnt vmcnt(0)" ::: "memory");
    __syncthreads();
    if (threadIdx.x == 0) {
        unsigned* bar = b.bar;
        __builtin_amdgcn_s_waitcnt(0);
        unsigned nloc = b.st[0], nx = b.st[1];
        if (nloc == 0u) { xcd_barrier_complete(bar, b.x, nloc, nx); b.st[0] = nloc; b.st[1] = nx; }
        const unsigned old = xb_add(&bar[XB_XSUB(b.x)], 1u);
        const unsigned gen = old / nloc;
        if (old + 1u == (gen + 1u) * nloc) {
            __builtin_amdgcn_fence(__ATOMIC_RELEASE, "agent");
            asm volatile("s_waitcnt vmcnt(0)" ::: "memory");
            const unsigned og = xb_add(&bar[XB_TOP], 1u);
            const unsigned tg = og / nx;
            if (og + 1u == (tg + 1u) * nx) xb_add(&bar[XB_TOPGEN], 1u);
            else XB_SPIN(xb_ld(&bar[XB_TOPGEN]) == tg, bar);
            __builtin_amdgcn_fence(__ATOMIC_ACQUIRE, "agent");
            xb_add(&bar[XB_XGEN(b.x)], 1u);
            asm volatile("s_waitcnt vmcnt(0)" ::: "memory");
        } else {
            XB_SPIN(xb_ld(&bar[XB_XGEN(b.x)]) == gen, bar);
            __builtin_amdgcn_fence(__ATOMIC_ACQUIRE, "agent");
            asm volatile("s_waitcnt vmcnt(0)" ::: "memory");
        }
    }
    __syncthreads();
}

__global__ void __launch_bounds__(512, 2) fwd_megakernel(Params p) {
    extern __shared__ __attribute__((aligned(16))) unsigned char shm[];
    LAS unsigned char* lds = (LAS unsigned char*)shm;
    cg::grid_group grid = cg::this_grid();
    volatile LAS unsigned* bst = (volatile LAS unsigned*)(lds + LDS_STAGE);
    if (threadIdx.x < 2) bst[threadIdx.x] = 0u;
    __syncthreads();
    const XcdBarrier xbar = xcd_barrier_post((unsigned*)(p.ws + WS_BAR), bst);
    if (p.ws == nullptr) grid.sync();
#define GRID_SYNC() xcd_barrier(xbar)
#ifndef TIME_PHASE
#define TIME_PHASE -1
#endif
#define T_BEGIN(k) do { if (TIME_PHASE == (k) && threadIdx.x == 0) bst[4] = (unsigned)__builtin_amdgcn_s_memrealtime(); } while (0)
#define T_END(k) do { if (TIME_PHASE == (k) && threadIdx.x == 0) bst[5] = (unsigned)__builtin_amdgcn_s_memrealtime() - bst[4]; } while (0)
    const int G = gridDim.x;
    unsigned char* ws = p.ws;
    EpiPtrs E; E.ws = ws; E.out = p.out; E.x = p.x; E.bout = p.b_out;

    T_BEGIN(0); phase_prep(p, lds, G);
    GRID_SYNC(); T_END(0);
    T_BEGIN(1); phase_hx(p, G);
    GRID_SYNC(); T_END(1);
    T_BEGIN(2);
    {
        pg8::Gemm g{(const bf16_t*)(ws + WS_A0), (const bf16_t*)(ws + WS_WIN), M_ALL, N_STATE_PAD, D};
        pg8::StateOrder S; S.init(M_LAT, N_STATE_PAD, G, (int)blockIdx.x);
        Epi<0> e{E};
        pg8::gemm_phase(lds, g, S, e);
        const int total = 832 + 72, rounds = (total + G - 1) / G, full = total - (rounds - 1) * G;
        const int nshort = full < G ? G - full : 0;
        const int c = (int)blockIdx.x;
        phase_prep_rest(p, lds, nshort ? (c >= full ? c - full : -1) : c, nshort ? nshort : G);
    }
    GRID_SYNC(); T_END(2);
    T_BEGIN(3); phase_scan(p, lds, G);
    GRID_SYNC(); T_END(3);
    T_BEGIN(4);
    {
        pg8::Gemm g{(const bf16_t*)(ws + WS_A0), (const bf16_t*)(ws + WS_WIN) + (size_t)N_STATE_PAD * D, M_LAT, N_REST, D};
        pg8::StaticOrder S; S.init(M_LAT, N_REST, G, (int)blockIdx.x);
        Epi<1> e{E};
        pg8::gemm_phase(lds, g, S, e);
    }
    GRID_SYNC(); T_END(4);
    T_BEGIN(5); phase_mix(p, G);
    GRID_SYNC(); T_END(5);
    T_BEGIN(6);
    {
        pg8::Gemm g{(const bf16_t*)(ws + WS_K), (const bf16_t*)(ws + WS_WPA), M_LAT, D, D};
        pg8::PairOrder S; S.init(M_LAT, D, G, (int)blockIdx.x);
        Epi<2> e{E};
        pg8::gemm_phase(lds, g, S, e);
    }
    GRID_SYNC(); T_END(6);
    T_BEGIN(7);
    {
        pg8::StaticOrder S; S.init(M_LAT, D, G, (int)blockIdx.x);
        pg8::Gemm g{(const bf16_t*)(ws + WS_A0), (const bf16_t*)(ws + WS_WOUT), M_LAT, D, D}; Epi<4> e{E}; pg8::gemm_phase(lds, g, S, e);
    }
    GRID_SYNC(); T_END(7);
    T_BEGIN(8); phase_final(p, G); T_END(8);
    if (TIME_PHASE >= 0 && blockIdx.x == 0 && threadIdx.x == 0) { const unsigned t0 = (unsigned)__builtin_amdgcn_s_memrealtime(), w = 8u * bst[5]; while ((unsigned)__builtin_amdgcn_s_memrealtime() - t0 < w) __builtin_amdgcn_s_sleep(8); }
}

extern "C" void kernel_launch(void* const* d_in, const int* in_sizes, int n_in, void* d_out, int out_size, void* d_ws, size_t ws_size, hipStream_t stream) {
    static int grid_blocks = 0;
    if (!grid_blocks) {
        int dev = 0, cus = 0, per_cu = 0;
        hipGetDevice(&dev);
        hipDeviceGetAttribute(&cus, hipDeviceAttributeMultiprocessorCount, dev);
        if (hipFuncSetAttribute((const void*)fwd_megakernel, hipFuncAttributeMaxDynamicSharedMemorySize, LDS_BYTES) != hipSuccess) fprintf(stderr, "kernel_launch: hipFuncSetAttribute failed\n");
        if (hipOccupancyMaxActiveBlocksPerMultiprocessor(&per_cu, (const void*)fwd_megakernel, 512, LDS_BYTES) != hipSuccess || per_cu < 1) { fprintf(stderr, "kernel_launch: occupancy query gave %d\n", per_cu); per_cu = 1; }
        grid_blocks = cus * per_cu;
        if (grid_blocks > 256) grid_blocks = 256;
        if (ws_size < WS_END) fprintf(stderr, "kernel_launch: workspace too small: %zu < %zu\n", ws_size, (size_t)WS_END);
    }
    Params p{};
    p.x = (const float*)d_in[0]; p.c = (const float*)d_in[1]; p.ctx = (const float*)d_in[2]; p.c_ctx = (const float*)d_in[3];
    p.w_ada = (const float*)d_in[4]; p.b_ada = (const float*)d_in[5]; p.g_norm = (const float*)d_in[6]; p.w_in = (const float*)d_in[7]; p.b_in = (const float*)d_in[8];
    p.w_conv = (const float*)d_in[9]; p.b_conv = (const float*)d_in[10]; p.g_head = (const float*)d_in[11]; p.w_pa = (const float*)d_in[12]; p.w_pb = (const float*)d_in[13];
    p.w_out = (const float*)d_in[14]; p.b_out = (const float*)d_in[15]; p.g_final = (const float*)d_in[16];
    p.out = (float*)d_out; p.ws = (unsigned char*)d_ws;
    (void)hipMemsetAsync((unsigned char*)d_ws + WS_BAR, 0, XCD_BAR_WORDS * 4, stream);
    void* args[] = {&p};
    hipError_t e = hipLaunchCooperativeKernel((const void*)fwd_megakernel, dim3(grid_blocks), dim3(512), args, LDS_BYTES, stream);
    if (e != hipSuccess) fprintf(stderr, "cooperative launch failed: %s (grid %d)\n", hipGetErrorString(e), grid_blocks);
}
```

```cpp
#include <hip/hip_runtime.h>
#include <hip/hip_cooperative_groups.h>
#include <cstdio>
#include <cstdint>
namespace cg = cooperative_groups;

#define LAS __attribute__((address_space(3)))
typedef unsigned short bf16_t;
typedef short bf16x8 __attribute__((ext_vector_type(8)));
typedef float f32x4 __attribute__((ext_vector_type(4)));
typedef unsigned u32x4 __attribute__((ext_vector_type(4)));
typedef unsigned u32x2 __attribute__((ext_vector_type(2)));

constexpr int D = 1024, NB = 8, SEQ = 2048, CTXL = 256, NH = 8, HD = 128;
constexpr int M_LAT = NB * SEQ, M_CTX = NB * CTXL, M_ALL = M_LAT + M_CTX;
constexpr int N_IN = 11296, N_PAD = 11520, N_STATE_PAD = 3328, N_REST = 8192;
constexpr int LSCAN = CTXL + SEQ;
constexpr float EPS = 1e-6f;
constexpr float QSCALE = 0.08838834764831845f;
constexpr int LDS_STAGE = 131072, LDS_BYTES = LDS_STAGE + 64;

constexpr size_t MiB = 1024 * 1024;
constexpr size_t WS_MOD = 0;
constexpr size_t WS_BIAS = 128 * 1024;
constexpr size_t WS_BAR = 176 * 1024;
constexpr size_t WS_GATES = 192 * 1024;
constexpr size_t WS_WIN = WS_GATES + (size_t)M_ALL * 32 * 4;
constexpr size_t WS_WPA = WS_WIN + (size_t)N_PAD * D * 2;
constexpr size_t WS_WPB = WS_WPA + 2 * MiB;
constexpr size_t WS_WOUT = WS_WPB + 2 * MiB;
constexpr size_t WS_A0 = WS_WOUT + 2 * MiB;
constexpr size_t WS_Q = WS_A0 + 36 * MiB;
constexpr size_t WS_K = WS_Q + 36 * MiB;
constexpr size_t WS_V = WS_K + 36 * MiB;
constexpr size_t WS_HF = WS_V + 36 * MiB;
constexpr size_t WS_HB = WS_HF + 32 * MiB;
constexpr size_t WS_END = WS_HB + 32 * MiB;

typedef __bf16 hbf16x2 __attribute__((ext_vector_type(2)));
typedef float f32x2v __attribute__((ext_vector_type(2)));
__device__ __forceinline__ unsigned cvt_pk_bf16(float lo, float hi) { const hbf16x2 r = __builtin_convertvector((f32x2v){lo, hi}, hbf16x2); return __builtin_bit_cast(unsigned, r); }
__device__ __forceinline__ float bf_lo(unsigned w) { return __uint_as_float(w << 16); }
__device__ __forceinline__ float bf_hi(unsigned w) { return __uint_as_float(w & 0xffff0000u); }
__device__ __forceinline__ float bf1(bf16_t b) { return __uint_as_float(((unsigned)b) << 16); }
__device__ __forceinline__ float fsigmoid(float x) { return __builtin_amdgcn_rcpf(1.0f + __expf(-x)); }
__device__ __forceinline__ float fsilu(float x) { return x * fsigmoid(x); }
__device__ __forceinline__ float wave_sum(float v) {
#pragma unroll
    for (int o = 1; o < 64; o <<= 1) v += __shfl_xor(v, o);
    return v;
}

namespace pg8 {
constexpr int BM = 256, BK = 64, HALF = 128, HTB = HALF * BK * 2, STAGE_BYTES = 8 * HTB, NXCD = 8, WGM = 8;
__host__ __device__ __forceinline__ int lds_byte(int r, int c) { const int st = (r >> 4) * 2 + (c >> 5), rr = r & 15, cc = c & 31, ob = rr * 64 + cc * 2; return st * 1024 + (ob ^ (((ob >> 9) & 1) << 5)); }
__host__ __device__ __forceinline__ void stage_rc(int b, int& R, int& C) { const int st = b / 1024, sb = b % 1024, swz = sb ^ (((sb >> 9) & 1) << 5); R = (st >> 1) * 16 + swz / 64; C = (st & 1) * 32 + (swz % 64) / 2; }
__host__ __device__ __forceinline__ int perm32(int rho) { const int n = rho >> 4, i = rho & 15; return 8 * (i >> 2) + 4 * n + (i & 3); }
struct Unit { int pm, pn; };
struct Gemm { const bf16_t* A; const bf16_t* Bt; int M, N, K; };
struct StaticOrder {
    int nM, nN, nwg, G, c;
    __host__ __device__ void init(int M, int N, int G_, int c_) { nM = M / BM; nN = N / BM; nwg = nM * nN; G = G_; c = c_; }
    __host__ __device__ bool map(long L, Unit& u) const {
        if (L >= nwg) return false;
        int wgid = (int)L; { const int q = nwg / NXCD, r = nwg % NXCD, xcd = wgid % NXCD, off = wgid / NXCD; wgid = (xcd < r ? xcd * (q + 1) : r * (q + 1) + (xcd - r) * q) + off; }
        const int nig = WGM * nN, gid = wgid / nig, fm = gid * WGM, gsz = (nM - fm) < WGM ? (nM - fm) : WGM;
        u.pm = fm + ((wgid % nig) % gsz); u.pn = (wgid % nig) / gsz; return true;
    }
    __host__ __device__ bool next(int i, Unit& u) const { return map((long)i * G + c, u); }
    __device__ __forceinline__ void a_ready(const Unit&) const {}
    __device__ __forceinline__ void done(const Unit&) const {}
};
struct StateOrder : StaticOrder {
    __host__ __device__ bool next(int i, Unit& u) const {
        const long L = (long)i * G + c;
        if (L < nwg) return map(L, u);
        const int idx = (int)(L - nwg); if (idx >= 72) return false;
        u.pm = 64 + (idx & 7); u.pn = 4 + (idx >> 3); return true;
    }
};

struct PairOrder : StaticOrder {
    __host__ __device__ bool next(int i, Unit& u) const {
        if (!map((long)(i >> 1) * G + c, u)) return false;
        if (i & 1) { u.pm += 72; u.pn += 4; }
        return true;
    }
};

template <class Epi, class Sched>
__device__ __forceinline__ void gemm_phase(LAS unsigned char* lds, const Gemm g, const Sched& S, const Epi& E) {
    int tid = threadIdx.x; asm volatile("" : "+v"(tid));
    const int wid = __builtin_amdgcn_readfirstlane(tid >> 6), lane = tid & 63, wr = wid >> 2, wc = wid & 3, fr = lane & 15, fq = lane >> 4;
    const int K = g.K, nt = K / BK;
    unsigned voffA[2], voffB[2];
#pragma unroll
    for (int i = 0; i < 2; ++i) { int R, C; stage_rc(tid * 16 + i * 8192, R, C); const int Rb = Epi::PERM ? ((R & ~31) + perm32(R & 31)) : R;
        voffA[i] = (unsigned)(R * K + C) * 2u; voffB[i] = (unsigned)(Rb * K + C) * 2u; }
    const size_t kstep = (size_t)(BK * 2);
    const size_t hstep = (size_t)HALF * K * 2;
    const size_t tstep = 2 * hstep;
    const unsigned ldsw = (unsigned)wid * 1024u;
    const int aoff = lds_byte(wr * 64 + fr, fq * 8), boff = lds_byte(wc * 32 + fr, fq * 8);
#define PG8_SA(b, h) (((b) * 2 + (h)) * HTB)
#define PG8_SB(b, h) ((4 + (b) * 2 + (h)) * HTB)
#define PG8_STAGE(bufoff, gbase, voff) do { _Pragma("unroll") for (int _i = 0; _i < 2; ++_i) \
        __builtin_amdgcn_global_load_lds((const unsigned*)((const char*)(gbase) + (voff)[_i]), (LAS unsigned*)(lds + (bufoff) + ldsw + _i * 8192), 16, 0, 0); } while (0)
#define PG8_LDA(dst, b, h) do { _Pragma("unroll") for (int m = 0; m < 4; ++m) _Pragma("unroll") for (int k = 0; k < 2; ++k) dst[m][k] = *(const LAS bf16x8*)(lds + PG8_SA(b, h) + aoff + m * 2048 + k * 1024); } while (0)
#define PG8_LDB(dst, b, h) do { _Pragma("unroll") for (int n = 0; n < 2; ++n) _Pragma("unroll") for (int k = 0; k < 2; ++k) dst[n][k] = *(const LAS bf16x8*)(lds + PG8_SB(b, h) + boff + n * 2048 + k * 1024); } while (0)
#define PG8_MMA(ai, bj, At, Bt) do { __builtin_amdgcn_s_setprio(1); _Pragma("unroll") for (int m = 0; m < 4; ++m) _Pragma("unroll") for (int n = 0; n < 2; ++n) _Pragma("unroll") for (int k = 0; k < 2; ++k) \
        acc[ai][bj][m][n] = __builtin_amdgcn_mfma_f32_16x16x32_bf16(Bt[n][k], At[m][k], acc[ai][bj][m][n], 0, 0, 0); __builtin_amdgcn_s_setprio(0); } while (0)
#define PG8_WAIT_V(n) asm volatile("s_waitcnt vmcnt(" #n ")" ::: "memory")
#define PG8_WAIT_L(n) asm volatile("s_waitcnt lgkmcnt(" #n ")" ::: "memory")
#define PG8_BAR __builtin_amdgcn_s_barrier()
#define PG8_SCHED __builtin_amdgcn_sched_barrier(0)
    Unit cur, nxt; int ui = 0;
    if (!S.next(0, cur)) return;
    f32x4 acc[2][2][4][2];
#pragma unroll
    for (int a = 0; a < 2; ++a)
#pragma unroll
        for (int b = 0; b < 2; ++b)
#pragma unroll
            for (int m = 0; m < 4; ++m)
#pragma unroll
                for (int n = 0; n < 2; ++n) acc[a][b][m][n] = (f32x4){0.f, 0.f, 0.f, 0.f};
    bf16x8 At[4][2], B0[2][2], B1[2][2];
    const char* cA = (const char*)g.A + (size_t)cur.pm * tstep; const char* cB = (const char*)g.Bt + (size_t)cur.pn * tstep;
    S.a_ready(cur);
    PG8_STAGE(PG8_SB(0, 0), cB, voffB); PG8_STAGE(PG8_SA(0, 0), cA, voffA); PG8_STAGE(PG8_SB(0, 1), cB + hstep, voffB); PG8_STAGE(PG8_SA(0, 1), cA + hstep, voffA);
    if (wr == 1) PG8_BAR;
    PG8_WAIT_V(4); PG8_BAR;
    PG8_STAGE(PG8_SB(1, 0), cB + kstep, voffB); PG8_STAGE(PG8_SA(1, 0), cA + kstep, voffA); PG8_STAGE(PG8_SB(1, 1), cB + hstep + kstep, voffB);
    PG8_WAIT_V(6); PG8_BAR;
    for (;;) {
        const bool has_next = S.next(ui + 1, nxt);
        const char* nA = has_next ? (const char*)g.A + (size_t)nxt.pm * tstep : cA; const char* nB = has_next ? (const char*)g.Bt + (size_t)nxt.pn * tstep : cB;
        for (int t = 0; t < nt; t += 2) {
            const bool last = (t == nt - 2);
            const char* a1 = cA + (size_t)(t + 1) * kstep;
            const char* a2 = last ? nA : cA + (size_t)(t + 2) * kstep; const char* b2 = last ? nB : cB + (size_t)(t + 2) * kstep;
            const char* a3 = a2 + kstep; const char* b3 = b2 + kstep;
            if (last && has_next) S.a_ready(nxt);
            PG8_LDB(B0, 0, 0); PG8_SCHED; PG8_LDA(At, 0, 0); PG8_STAGE(PG8_SA(1, 1), a1 + hstep, voffA);
            PG8_WAIT_L(8); PG8_BAR; PG8_WAIT_L(0); PG8_MMA(0, 0, At, B0); PG8_BAR; PG8_SCHED;
            PG8_LDB(B1, 0, 1); PG8_STAGE(PG8_SB(0, 0), b2, voffB);
            PG8_BAR; PG8_WAIT_L(0); PG8_MMA(0, 1, At, B1); PG8_BAR;
            PG8_LDA(At, 0, 1); PG8_STAGE(PG8_SA(0, 0), a2, voffA);
            PG8_BAR; PG8_WAIT_L(0); PG8_MMA(1, 0, At, B0); PG8_BAR; PG8_SCHED;
            PG8_STAGE(PG8_SB(0, 1), b2 + hstep, voffB);
            PG8_WAIT_V(6); PG8_BAR; PG8_MMA(1, 1, At, B1); PG8_BAR;
            PG8_LDB(B0, 1, 0); PG8_SCHED; PG8_LDA(At, 1, 0); PG8_STAGE(PG8_SA(0, 1), a2 + hstep, voffA);
            PG8_WAIT_L(8); PG8_BAR; PG8_WAIT_L(0); PG8_MMA(0, 0, At, B0); PG8_BAR; PG8_SCHED;
            PG8_LDB(B1, 1, 1); PG8_STAGE(PG8_SB(1, 0), b3, voffB);
            PG8_BAR; PG8_WAIT_L(0); PG8_MMA(0, 1, At, B1); PG8_BAR;
            PG8_LDA(At, 1, 1); PG8_STAGE(PG8_SA(1, 0), a3, voffA);
            PG8_BAR; PG8_WAIT_L(0); PG8_MMA(1, 0, At, B0); PG8_BAR; PG8_SCHED;
            PG8_STAGE(PG8_SB(1, 1), b3 + hstep, voffB);
            PG8_WAIT_V(6); PG8_BAR; PG8_MMA(1, 1, At, B1); PG8_BAR;
        }
        E(acc, cur, wr, wc, fr, fq); S.done(cur);
        if (!has_next) break;
        if (!E.keep(cur)) {
#pragma unroll
            for (int a = 0; a < 2; ++a)
#pragma unroll
                for (int b = 0; b < 2; ++b)
#pragma unroll
                    for (int m = 0; m < 4; ++m)
#pragma unroll
                        for (int n = 0; n < 2; ++n) acc[a][b][m][n] = (f32x4){0.f, 0.f, 0.f, 0.f};
        }
        cur = nxt; cA = nA; cB = nB; ++ui;
    }
    PG8_WAIT_V(0);
    if (wr == 0) PG8_BAR;
    PG8_BAR;
#undef PG8_SA
#undef PG8_SB
#undef PG8_STAGE
#undef PG8_LDA
#undef PG8_LDB
#undef PG8_MMA
#undef PG8_WAIT_V
#undef PG8_WAIT_L
#undef PG8_BAR
#undef PG8_SCHED
}
}

struct EpiPtrs { unsigned char* ws; float* out; const float* x; const float* bout; const float* wconv; const float* bconv; };
struct EpiView {
    bf16_t *Q, *K, *V, *U, *BZ, *OZ, *SGA, *SGB, *MERGED;
    float *GATES, *TMP, *OUT;
    const float *BIAS, *X, *MOD, *BOUT, *WCONV, *BCONV;
    __device__ __forceinline__ EpiView(const EpiPtrs& e) {
        unsigned char* ws = e.ws;
        Q = (bf16_t*)(ws + WS_Q); K = (bf16_t*)(ws + WS_K); V = (bf16_t*)(ws + WS_V); U = Q; BZ = K; OZ = V;
        SGA = (bf16_t*)e.out; SGB = (bf16_t*)e.out + (size_t)M_LAT * D; MERGED = (bf16_t*)(ws + WS_A0);
        GATES = (float*)(ws + WS_GATES); TMP = (float*)(ws + WS_HF); OUT = e.out;
        BIAS = (const float*)(ws + WS_BIAS); X = e.x; MOD = (const float*)(ws + WS_MOD); BOUT = e.bout; WCONV = e.wconv; BCONV = e.bconv;
    }
};
__device__ __forceinline__ u32x4 pack8(const f32x4 a, const f32x4 b) { u32x4 w; w.x = cvt_pk_bf16(a[0], a[1]); w.y = cvt_pk_bf16(a[2], a[3]); w.z = cvt_pk_bf16(b[0], b[1]); w.w = cvt_pk_bf16(b[2], b[3]); return w; }
__device__ __forceinline__ void unpack8(const u32x4 w, f32x4& a, f32x4& b) { a = (f32x4){bf_lo(w.x), bf_hi(w.x), bf_lo(w.y), bf_hi(w.y)}; b = (f32x4){bf_lo(w.z), bf_hi(w.z), bf_lo(w.w), bf_hi(w.w)}; }

template <int T> __device__ __forceinline__ void fused_pair(const f32x4 (&acc)[2][2][4][2], const f32x4 (&bv)[2][2], bf16_t* base) {
#pragma unroll
    for (int ai = 0; ai < 2; ++ai)
#pragma unroll
        for (int m = 0; m < 4; ++m) {
            f32x4 r[2];
#pragma unroll
            for (int n = 0; n < 2; ++n) {
                const f32x4 a = acc[ai][0][m][n] + bv[0][n], c = acc[ai][1][m][n] + bv[1][n];
#pragma unroll
                for (int x = 0; x < 4; ++x) {
                    if (T == 0) r[n][x] = a[x] * c[x];
                    else if (T == 1) r[n][x] = a[x] * c[x] * __builtin_amdgcn_rcpf(1.0f + __expf(-c[x]));
                    else r[n][x] = c[x] * __builtin_amdgcn_rcpf((1.0f + __expf(-a[x])) * (1.0f + __expf(-c[x])));
                }
            }
            *(u32x4*)(base + (size_t)(ai * 128 + m * 16) * D) = pack8(r[0], r[1]);
        }
}

template <int MODE> struct Epi {
    static constexpr bool PERM = true;
    EpiPtrs PP;
    __device__ __forceinline__ bool keep(const pg8::Unit& u) const { return MODE == 2 && u.pm < 72; }
    __device__ __forceinline__ void operator()(f32x4 (&acc)[2][2][4][2], const pg8::Unit& u, int wr, int wc, int fr, int fq) const {
        const EpiView P(PP);
        const int row0 = u.pm * 256 + wr * 64 + fr;
        const int lc = wc * 32 + 8 * fq;
        if constexpr (MODE == 0) {
            const int pn = u.pn;
            if (pn < 12) {
                bf16_t* base = pn < 4 ? P.Q : (pn < 8 ? P.K : P.V);
                const float sc = pn < 4 ? QSCALE : 1.0f;
                const int cb = (pn & 3) * 256 + lc;
#pragma unroll
                for (int bj = 0; bj < 2; ++bj) {
                    const f32x4 bv0 = *(const f32x4*)(P.BIAS + pn * 256 + bj * 128 + lc), bv1 = *(const f32x4*)(P.BIAS + pn * 256 + bj * 128 + lc + 4);
#pragma unroll
                    for (int ai = 0; ai < 2; ++ai)
#pragma unroll
                        for (int m = 0; m < 4; ++m) {
                            const f32x4 v0 = (acc[ai][bj][m][0] + bv0) * sc, v1 = (acc[ai][bj][m][1] + bv1) * sc;
                            *(u32x4*)(base + (size_t)(row0 + ai * 128 + m * 16) * D + cb + bj * 128) = pack8(v0, v1);
                        }
                }
            } else if (wc == 0) {
                const f32x4 b0 = *(const f32x4*)(P.BIAS + 3072 + 8 * fq), b1 = *(const f32x4*)(P.BIAS + 3072 + 8 * fq + 4);
#pragma unroll
                for (int ai = 0; ai < 2; ++ai)
#pragma unroll
                    for (int m = 0; m < 4; ++m) {
                        float* gp = P.GATES + (size_t)(row0 + ai * 128 + m * 16) * 32 + 8 * fq;
                        *(f32x4*)gp = acc[ai][0][m][0] + b0; *(f32x4*)(gp + 4) = acc[ai][0][m][1] + b1;
                    }
            }
        } else if constexpr (MODE == 1) {
            const int pn = u.pn;
            const float* bp = P.BIAS + N_STATE_PAD + pn * 256 + lc;
            f32x4 bv[2][2];
#pragma unroll
            for (int bj = 0; bj < 2; ++bj)
#pragma unroll
                for (int n = 0; n < 2; ++n) bv[bj][n] = *(const f32x4*)(bp + bj * 128 + 4 * n);
            if (pn < 16) {
                const int feat = 64 * pn + 16 * wc + 4 * fq;
                const f32x4 w0 = *(const f32x4*)(P.WCONV + feat), w1 = *(const f32x4*)(P.WCONV + D + feat), w2 = *(const f32x4*)(P.WCONV + 2 * D + feat), bc = *(const f32x4*)(P.BCONV + feat);
                const int lane = (fq << 4) | fr, ldn = (fq << 4) | ((fr + 15) & 15), lup = (fq << 4) | ((fr + 1) & 15);
                (void)lane;
#pragma unroll
                for (int ai = 0; ai < 2; ++ai) {
                    f32x4 uu[4], rd[4], ru[4];
#pragma unroll
                    for (int m = 0; m < 4; ++m) { uu[m] = (acc[ai][0][m][0] + bv[0][0]) * (acc[ai][0][m][1] + bv[0][1]);
#pragma unroll
                        for (int x = 0; x < 4; ++x) { rd[m][x] = __shfl(uu[m][x], ldn); ru[m][x] = __shfl(uu[m][x], lup); } }
#pragma unroll
                    for (int m = 0; m < 4; ++m) {
                        const f32x4 zero = (f32x4){0.f, 0.f, 0.f, 0.f};
                        const f32x4 prev = fr > 0 ? rd[m] : (m > 0 ? rd[m > 0 ? m - 1 : 0] : zero);
                        const f32x4 next = fr < 15 ? ru[m] : (m < 3 ? ru[m < 3 ? m + 1 : 3] : zero);
                        const f32x4 bb = acc[ai][1][m][0] + bv[1][0], z = acc[ai][1][m][1] + bv[1][1];
                        const f32x4 cv = w0 * prev + w1 * uu[m] + w2 * next + bc;
                        f32x4 y;
#pragma unroll
                        for (int x = 0; x < 4; ++x) y[x] = bb[x] * z[x] * __builtin_amdgcn_rcpf(1.0f + __expf(-z[x])) * cv[x];
                        u32x2 o; o.x = cvt_pk_bf16(y[0], y[1]); o.y = cvt_pk_bf16(y[2], y[3]);
                        *(u32x2*)(P.BZ + (size_t)(row0 + ai * 128 + m * 16) * D + feat) = o;
                    }
                }
            } else if (pn < 24) {
                bf16_t* base = P.OZ + (size_t)row0 * D + (pn & 7) * 128 + lc;
                fused_pair<2>(acc, bv, base);
            } else {
                bf16_t* base = pn < 28 ? P.SGA : P.SGB;
                const int cb = (pn & 3) * 256 + lc;
#pragma unroll
                for (int ai = 0; ai < 2; ++ai)
#pragma unroll
                    for (int m = 0; m < 4; ++m) {
                        bf16_t* rowp = base + (size_t)(row0 + ai * 128 + m * 16) * D + cb;
#pragma unroll
                        for (int bj = 0; bj < 2; ++bj) {
                            f32x4 r[2];
#pragma unroll
                            for (int n = 0; n < 2; ++n) { const f32x4 a = acc[ai][bj][m][n] + bv[bj][n];
#pragma unroll
                                for (int x = 0; x < 4; ++x) r[n][x] = fsigmoid(a[x]); }
                            *(u32x4*)(rowp + bj * 128) = pack8(r[0], r[1]);
                        }
                    }
            }
        } else if constexpr (MODE == 2) {
            if (u.pm < 72) {
                const int cb = u.pn * 256 + lc;
#pragma unroll
                for (int ai = 0; ai < 2; ++ai)
#pragma unroll
                    for (int m = 0; m < 4; ++m) {
                        const size_t ro = (size_t)(row0 + ai * 128 + m * 16) * D + cb;
#pragma unroll
                        for (int bj = 0; bj < 2; ++bj) {
                            f32x4 a0, a1, b0, b1; unpack8(*(const u32x4*)(P.SGA + ro + bj * 128), a0, a1); unpack8(*(const u32x4*)(P.SGB + ro + bj * 128), b0, b1);
#pragma unroll
                            for (int x = 0; x < 4; ++x) { acc[ai][bj][m][0][x] *= a0[x] * __builtin_amdgcn_rcpf(b0[x]); acc[ai][bj][m][1][x] *= a1[x] * __builtin_amdgcn_rcpf(b1[x]); }
                        }
                    }
            } else {
                const int cb = (u.pn - 4) * 256 + lc, r0 = row0 - 72 * 256;
#pragma unroll
                for (int ai = 0; ai < 2; ++ai)
#pragma unroll
                    for (int m = 0; m < 4; ++m) {
                        const size_t ro = (size_t)(r0 + ai * 128 + m * 16) * D + cb;
#pragma unroll
                        for (int bj = 0; bj < 2; ++bj) {
                            f32x4 g0, g1; unpack8(*(const u32x4*)(P.SGB + ro + bj * 128), g0, g1);
                            *(u32x4*)(P.MERGED + ro + bj * 128) = pack8(g0 * acc[ai][bj][m][0], g1 * acc[ai][bj][m][1]);
                        }
                    }
            }
        } else {
            const int cb = u.pn * 256 + lc;
            const int b = u.pm >> 3;
#pragma unroll
            for (int bj = 0; bj < 2; ++bj) {
                const f32x4 bo0 = *(const f32x4*)(P.BOUT + cb + bj * 128), bo1 = *(const f32x4*)(P.BOUT + cb + bj * 128 + 4);
                const f32x4 gt0 = *(const f32x4*)(P.MOD + b * 3072 + 2048 + cb + bj * 128), gt1 = *(const f32x4*)(P.MOD + b * 3072 + 2048 + cb + bj * 128 + 4);
#pragma unroll
                for (int ai = 0; ai < 2; ++ai) {
                    f32x4 xv[4][2];
#pragma unroll
                    for (int m = 0; m < 4; ++m) { const size_t ro = (size_t)(row0 + ai * 128 + m * 16) * D + cb + bj * 128;
                        xv[m][0] = *(const f32x4*)(P.X + ro); xv[m][1] = *(const f32x4*)(P.X + ro + 4); }
#pragma unroll
                    for (int m = 0; m < 4; ++m) { const size_t ro = (size_t)(row0 + ai * 128 + m * 16) * D + cb + bj * 128;
                        *(f32x4*)(P.OUT + ro) = xv[m][0] + gt0 * (acc[ai][bj][m][0] + bo0);
                        *(f32x4*)(P.OUT + ro + 4) = xv[m][1] + gt1 * (acc[ai][bj][m][1] + bo1); }
                }
            }
        }
    }
};

struct Params {
    const float *x, *c, *ctx, *c_ctx, *w_ada, *b_ada, *g_norm, *w_in, *b_in, *w_conv, *b_conv, *g_head, *w_pa, *w_pb, *w_out, *b_out, *g_final;
    float* out; unsigned char* ws;
};

__device__ __forceinline__ int src_col(int n) {
    if (n < 3104) return n;
    if (n < N_STATE_PAD) return -1;
    int r = n - N_STATE_PAD;
    if (r < 4096) {
        const int k = r >> 8, c = r & 255, bj = c >> 7, wc = (c >> 5) & 3, fq = (c >> 3) & 3, n = (c >> 2) & 1, x = c & 3;
        const int op = bj * 2 + n, j = 64 * k + 16 * wc + 4 * fq + x;
        return (op == 0 ? 6176 : (op == 1 ? 7200 : (op == 2 ? 5152 : 8224))) + j;
    }
    if (r < 6144) { const int u = (r >> 8) & 7, half = (r >> 7) & 1, x = r & 127; return (half ? 4128 : 3104) + 128 * u + x; }
    return 9248 + (r - 6144);
}
__device__ __forceinline__ void transpose_item(const float* W, int N, int ncol  , bf16_t* WT, int row_dst, int k0, LAS float* scr, int lane, int ya_op = -1) {
#pragma unroll 8
    for (int i = 0; i < 32; ++i) { const int kk = 2 * i + (lane >> 5); scr[kk * 33 + (lane & 31)] = ncol >= 0 ? W[(size_t)(k0 + kk) * N + ncol] : 0.f; }
    asm volatile("s_waitcnt vmcnt(0) lgkmcnt(0)" ::: "memory");
    const int cch = lane & 7;
#pragma unroll
    for (int j = 0; j < 4; ++j) { const int n = (lane >> 3) + 8 * j; const LAS float* s = scr + (8 * cch) * 33 + n;
        u32x4 o; o.x = cvt_pk_bf16(s[0 * 33], s[1 * 33]); o.y = cvt_pk_bf16(s[2 * 33], s[3 * 33]); o.z = cvt_pk_bf16(s[4 * 33], s[5 * 33]); o.w = cvt_pk_bf16(s[6 * 33], s[7 * 33]);
        int drow = row_dst + n;
        if (ya_op >= 0) { const int f = row_dst + n;
            drow = N_STATE_PAD + 256 * (f >> 6) + 128 * (ya_op >> 1) + 32 * ((f >> 4) & 3) + 8 * ((f >> 2) & 3) + 4 * (ya_op & 1) + (f & 3); }
        *(u32x4*)(WT + (size_t)drow * D + k0 + 8 * cch) = o; }
    asm volatile("s_waitcnt lgkmcnt(0)" ::: "memory");
}

__device__ __forceinline__ int opaque_tid() { int t = threadIdx.x; asm volatile("" : "+v"(t)); return t; }
__device__ __forceinline__ void phase_prep(const Params& p, LAS unsigned char* lds, int G) {
    const int tid = opaque_tid(), lane = tid & 63, wave = tid >> 6;
    unsigned char* ws = p.ws;
    for (int task = blockIdx.x; task < 192; task += G) {
        LAS float* sc = (LAS float*)lds;
        LAS float* red = (LAS float*)(lds + 9 * 1024 * 4);
        {
            float cv[18];
#pragma unroll
            for (int q = 0; q < 18; ++q) { const int i = tid + 512 * q, r = i >> 10, k = i & 1023; cv[q] = r < 8 ? p.c[r * 1024 + k] : p.c_ctx[k]; }
#pragma unroll
            for (int q = 0; q < 18; ++q) sc[tid + 512 * q] = fsilu(cv[q]);
        }
        __syncthreads();
        const int nn = tid & 15, ks = tid >> 4, n0 = task * 16;
        float a[9];
#pragma unroll
        for (int r = 0; r < 9; ++r) a[r] = 0.f;
#pragma unroll
        for (int kb = 0; kb < 4; ++kb) {
            float w[8];
#pragma unroll
            for (int q = 0; q < 8; ++q) w[q] = p.w_ada[(size_t)(ks * 32 + kb * 8 + q) * 3072 + n0 + nn];
#pragma unroll
            for (int q = 0; q < 8; ++q)
#pragma unroll
                for (int r = 0; r < 9; ++r) a[r] += sc[r * 1024 + ks * 32 + kb * 8 + q] * w[q];
        }
#pragma unroll
        for (int r = 0; r < 9; ++r) red[(ks * 9 + r) * 16 + nn] = a[r];
        __syncthreads();
        if (tid < 144) { const int r = tid >> 4; float sum = p.b_ada[n0 + nn];
#pragma unroll
            for (int q = 0; q < 32; ++q) sum += red[(q * 9 + r) * 16 + nn];
            ((float*)(ws + WS_MOD))[r * 3072 + n0 + nn] = sum; }
        __syncthreads();
    }
    for (int i = blockIdx.x * 512 + tid; i < N_PAD; i += G * 512) { const int s = src_col(i); ((float*)(ws + WS_BIAS))[i] = s >= 0 ? p.b_in[s] : 0.f; }
    LAS float* scr = (LAS float*)(lds + wave * 8448);
    const int gw = blockIdx.x * 8 + wave, NGW = G * 8;
    constexpr int I_ST = 16 * (N_STATE_PAD / 32);
    for (int it = gw; it < I_ST; it += NGW) { const int nb = it >> 4, kb = it & 15; transpose_item(p.w_in, N_IN, src_col(nb * 32 + (lane & 31)), (bf16_t*)(p.ws + WS_WIN), nb * 32, kb * 64, scr, lane); }
}
__device__ __forceinline__ void phase_prep_rest(const Params& p, LAS unsigned char* lds, int sidx, int nshort) {
    const int tid = opaque_tid(), lane = tid & 63, wave = tid >> 6;
    if (sidx < 0) return;
    LAS float* scr = (LAS float*)(lds + wave * 8448);
    const int gw = sidx * 8 + wave, NGW = nshort * 8;
    constexpr int I_REST = 16 * (N_REST / 32), I_SQ = 16 * 32;
    for (int it = gw; it < I_REST + 3 * I_SQ; it += NGW) {
        if (it < 2048) { const int kb = it & 15, jb = (it >> 4) & 31, op = it >> 9;
            const int base = op == 0 ? 6176 : (op == 1 ? 7200 : (op == 2 ? 5152 : 8224));
            transpose_item(p.w_in, N_IN, base + jb * 32 + (lane & 31), (bf16_t*)(p.ws + WS_WIN), jb * 32, kb * 64, scr, lane, op); }
        else if (it < I_REST) { const int nb = (it >> 4) + N_STATE_PAD / 32, kb = it & 15; transpose_item(p.w_in, N_IN, src_col(nb * 32 + (lane & 31)), (bf16_t*)(p.ws + WS_WIN), nb * 32, kb * 64, scr, lane); }
        else { int r = it - I_REST; const int which = r / I_SQ; r -= which * I_SQ; const int nb = r >> 4, kb = r & 15;
            const float* W = which == 0 ? p.w_pa : (which == 1 ? p.w_pb : p.w_out);
            bf16_t* WT = (bf16_t*)(p.ws + (which == 0 ? WS_WPA : (which == 1 ? WS_WPB : WS_WOUT)));
            transpose_item(W, D, nb * 32 + (lane & 31), WT, nb * 32, kb * 64, scr, lane); }
    }
}

__device__ __forceinline__ void phase_hx(const Params& p, int G) {
    const int tid = opaque_tid(), lane = tid & 63, wave = tid >> 6;
    const int gw = blockIdx.x * 8 + wave, NGW = G * 8;
    const float* MOD = (const float*)(p.ws + WS_MOD);
    bf16_t* A0 = (bf16_t*)(p.ws + WS_A0);
    const int per = (M_ALL + NGW - 1) / NGW;
    int curb = -1; f32x4 gs[4], sh[4];
    const int mend = min((gw + 1) * per, M_ALL);
    for (int m = gw * per; m < mend; m += 9) {
        f32x4 v[9][4];
#pragma unroll
        for (int q = 0; q < 9; ++q) { const int mm = min(m + q, mend - 1);
            const float* xr = mm < M_LAT ? p.x + (size_t)mm * D : p.ctx + (size_t)(mm - M_LAT) * D;
#pragma unroll
            for (int j = 0; j < 4; ++j) v[q][j] = *(const f32x4*)(xr + (lane + 64 * j) * 4); }
#pragma unroll
        for (int q = 0; q < 9; ++q) { const int mm = m + q; if (mm < mend) {
            const int b = mm < M_LAT ? (mm >> 11) : 8;
            if (b != curb) { curb = b;
#pragma unroll
                for (int j = 0; j < 4; ++j) { const int cidx = (lane + 64 * j) * 4;
                    const f32x4 g = *(const f32x4*)(p.g_norm + cidx), sv = *(const f32x4*)(MOD + b * 3072 + 1024 + cidx); sh[j] = *(const f32x4*)(MOD + b * 3072 + cidx); gs[j] = g * (sv + 1.0f); } }
            float ss = 0.f;
#pragma unroll
            for (int j = 0; j < 4; ++j) ss += (v[q][j][0] * v[q][j][0] + v[q][j][1] * v[q][j][1]) + (v[q][j][2] * v[q][j][2] + v[q][j][3] * v[q][j][3]);
            const float rstd = rsqrtf(wave_sum(ss) * (1.0f / D) + EPS);
#pragma unroll
            for (int j = 0; j < 4; ++j) { const f32x4 y = v[q][j] * rstd * gs[j] + sh[j];
                u32x2 o; o.x = cvt_pk_bf16(y[0], y[1]); o.y = cvt_pk_bf16(y[2], y[3]);
                *(u32x2*)(A0 + (size_t)mm * D + (lane + 64 * j) * 4) = o; }
        } }
    }
}

constexpr int SQ = 0, SK = 17408, SV = 34816, SKT = 44032, SVT = 62464, SC = 71680, SP = 89088, SA_ = 98304, SM_ = 107520, SB_ = 116736, SN = 125952, SQN = 126464, SRS = 126720;
constexpr int LQ = 272, LV = 144;

template <bool MAXOP> __device__ __forceinline__ float block_excl_scan256(float v, LAS float* buf, int t, float ident) {
    int cur = 0; if (t < 256) buf[t] = v; __syncthreads();
    for (int off = 1; off < 256; off <<= 1) {
        if (t < 256) { float x = buf[cur * 256 + t]; if (t >= off) { const float y = buf[cur * 256 + t - off]; x = MAXOP ? fmaxf(x, y) : x + y; } buf[(cur ^ 1) * 256 + t] = x; }
        __syncthreads(); cur ^= 1;
    }
    const float ex = (t < 256 && t > 0) ? buf[cur * 256 + t - 1] : ident;
    __syncthreads();
    return ex;
}

__device__ __forceinline__ int scan_row(int p, int b, int dir) {
    if (p < CTXL) return M_LAT + b * CTXL + (dir ? CTXL - 1 - p : p);
    const int q = p - CTXL; return b * SEQ + (dir ? SEQ - 1 - q : q);
}

__device__ __forceinline__ void phase_scan(const Params& p, LAS unsigned char* lds, int G) {
    const int tid = opaque_tid(), lane = tid & 63, wave = __builtin_amdgcn_readfirstlane(tid >> 6), fr = lane & 15, fq = lane >> 4;
    const bf16_t* Qg = (const bf16_t*)(p.ws + WS_Q); const bf16_t* Kg = (const bf16_t*)(p.ws + WS_K); const bf16_t* Vg = (const bf16_t*)(p.ws + WS_V);
    const float* GATES = (const float*)(p.ws + WS_GATES);
    LAS float* a_s = (LAS float*)(lds + SA_); LAS float* M_s = (LAS float*)(lds + SM_); LAS float* B_s = (LAS float*)(lds + SB_);
    LAS float* n_s = (LAS float*)(lds + SN); LAS float* qn_s = (LAS float*)(lds + SQN); LAS float* rs_s = (LAS float*)(lds + SRS);
    for (int item = blockIdx.x; item < 256; item += G) {
        const int dvh = item & 1, dir = (item >> 1) & 1, h = (item >> 2) & 7, b = item >> 5;
        bf16_t* Hout = (bf16_t*)(p.ws + (dir ? WS_HB : WS_HF));
        __syncthreads();
        {
            LAS float* buf = (LAS float*)(lds + SQ);
            float iv[9], lf[9]; float run = 0.f;
            if (tid < 256) {
#pragma unroll
                for (int e = 0; e < 9; ++e) { const int row = scan_row(tid * 9 + e, b, dir); const float* gp = GATES + (size_t)row * 32 + dir * 16 + h;
                    iv[e] = gp[0]; const float f = gp[8]; const float l = fminf(f, 0.f) - log1pf(__expf(-fabsf(f))); run += l; lf[e] = run; }
            }
            const float off = block_excl_scan256<false>(run, buf, tid, 0.f);
            float mx = -3.0e38f;
            if (tid < 256) {
#pragma unroll
                for (int e = 0; e < 9; ++e) { lf[e] += off; iv[e] -= lf[e]; mx = fmaxf(mx, iv[e]); }
            }
            const float moff = block_excl_scan256<true>(mx, buf, tid, 0.f);
            if (tid < 256) { float mr = fmaxf(moff, 0.f);
#pragma unroll
                for (int e = 0; e < 9; ++e) { const int pp = tid * 9 + e; mr = fmaxf(mr, iv[e]); a_s[pp] = iv[e]; M_s[pp] = mr; B_s[pp] = lf[e]; } }
            if (tid < 128) n_s[tid] = 0.f;
            for (int i = tid; i < 17408 / 16; i += 512) *(LAS u32x4*)(lds + SC + i * 16) = (u32x4){0u, 0u, 0u, 0u};
        }
        __syncthreads();
        f32x4 cacc[4];
#pragma unroll
        for (int te = 0; te < 4; ++te) cacc[te] = (f32x4){0.f, 0.f, 0.f, 0.f};
        u32x4 rq[2], rk[2], rv;
        const int colqk = h * HD + (tid & 15) * 8, colv = h * HD + dvh * 64 + (tid & 7) * 8;
#define ISSUE_LOADS(P0, EMIT) do { \
            _Pragma("unroll") for (int rep = 0; rep < 2; ++rep) { const size_t row = (size_t)scan_row((P0) + (tid >> 4) + 32 * rep, b, dir); \
                rk[rep] = *(const u32x4*)(Kg + row * D + colqk); \
                if (EMIT) rq[rep] = *(const u32x4*)(Qg + row * D + colqk); } \
            { const size_t row = (size_t)scan_row((P0) + (tid >> 3), b, dir); rv = *(const u32x4*)(Vg + row * D + colv); } } while (0)
        rq[0] = rq[1] = (u32x4){0u, 0u, 0u, 0u};
        ISSUE_LOADS(0, false);
        const int it = wave >> 1, sub = wave & 1;
        for (int ch = 0; ch < LSCAN / 64; ++ch) {
            const int p0 = ch * 64; const bool emit = p0 >= CTXL;
            __syncthreads();
#pragma unroll
            for (int rep = 0; rep < 2; ++rep) { const int r = (tid >> 4) + 32 * rep;
                *(LAS u32x4*)(lds + SK + r * LQ + (tid & 15) * 16) = rk[rep];
                if (emit) *(LAS u32x4*)(lds + SQ + r * LQ + (tid & 15) * 16) = rq[rep]; }
            *(LAS u32x4*)(lds + SV + (tid >> 3) * LV + (tid & 7) * 16) = rv;
            __syncthreads();
            if (ch + 1 < LSCAN / 64) ISSUE_LOADS(p0 + 64, (p0 + 64 >= CTXL));
            const float M_start = p0 > 0 ? M_s[p0 - 1] : 0.f, M_last = M_s[p0 + 63];
            const float decay = __expf(M_start - M_last);
            f32x4 hacc[2]; hacc[0] = (f32x4){0.f, 0.f, 0.f, 0.f}; hacc[1] = hacc[0];
            const int i_loc = it * 16 + fr;
            float M_i = 0.f, w_inter = 0.f;
            if (emit) {
                M_i = M_s[p0 + i_loc]; w_inter = __expf(M_start - M_i);
                f32x4 sacc[2]; sacc[0] = (f32x4){0.f, 0.f, 0.f, 0.f}; sacc[1] = sacc[0];
#pragma unroll
                for (int kk = 0; kk < 4; ++kk) {
                    const bf16x8 bq = *(const LAS bf16x8*)(lds + SQ + i_loc * LQ + (kk * 32 + fq * 8) * 2);
#pragma unroll
                    for (int t2 = 0; t2 < 2; ++t2) {
                        const bf16x8 ak = *(const LAS bf16x8*)(lds + SK + ((sub * 2 + t2) * 16 + fr) * LQ + (kk * 32 + fq * 8) * 2);
                        sacc[t2] = __builtin_amdgcn_mfma_f32_16x16x32_bf16(ak, bq, sacc[t2], 0, 0, 0);
                        const bf16x8 ac = *(const LAS bf16x8*)(lds + SC + ((sub * 2 + t2) * 16 + fr) * LQ + (kk * 32 + fq * 8) * 2);
                        hacc[t2] = __builtin_amdgcn_mfma_f32_16x16x32_bf16(ac, bq, hacc[t2], 0, 0, 0);
                    }
                }
                float rs = 0.f;
#pragma unroll
                for (int t2 = 0; t2 < 2; ++t2) {
                    const int j0 = (sub * 2 + t2) * 16 + 4 * fq;
                    const f32x4 av = *(const LAS f32x4*)(a_s + p0 + j0);
                    float pv[4];
#pragma unroll
                    for (int r = 0; r < 4; ++r) { const float e = (j0 + r <= i_loc) ? __expf(av[r] - M_i) : 0.f; pv[r] = sacc[t2][r] * e; rs += pv[r]; }
                    u32x2 o; o.x = cvt_pk_bf16(pv[0], pv[1]); o.y = cvt_pk_bf16(pv[2], pv[3]);
                    *(LAS u32x2*)(lds + SP + i_loc * LV + j0 * 2) = o;
                    hacc[t2] = hacc[t2] * w_inter;
                }
                rs += __shfl_xor(rs, 16); rs += __shfl_xor(rs, 32);
                if (fq == 0) rs_s[sub * 64 + i_loc] = rs;
                { const int qi = tid >> 3, part = tid & 7;
                    const u32x4 q0 = *(const LAS u32x4*)(lds + SQ + qi * LQ + part * 32), q1 = *(const LAS u32x4*)(lds + SQ + qi * LQ + part * 32 + 16);
                    const LAS float* np = n_s + part * 16;
                    float s = bf_lo(q0.x) * np[0] + bf_hi(q0.x) * np[1] + bf_lo(q0.y) * np[2] + bf_hi(q0.y) * np[3] + bf_lo(q0.z) * np[4] + bf_hi(q0.z) * np[5] + bf_lo(q0.w) * np[6] + bf_hi(q0.w) * np[7]
                            + bf_lo(q1.x) * np[8] + bf_hi(q1.x) * np[9] + bf_lo(q1.y) * np[10] + bf_hi(q1.y) * np[11] + bf_lo(q1.z) * np[12] + bf_hi(q1.z) * np[13] + bf_lo(q1.w) * np[14] + bf_hi(q1.w) * np[15];
                    s += __shfl_xor(s, 1); s += __shfl_xor(s, 2); s += __shfl_xor(s, 4);
                    if (part == 0) qn_s[qi] = s; }
            }
#pragma unroll
            for (int rep = 0; rep < 2; ++rep) { const int id = tid + 512 * rep, d = id & 127, jg = id >> 7, j0 = jg * 8;
                float kv[8];
#pragma unroll
                for (int x = 0; x < 8; ++x) kv[x] = bf1(*(const LAS bf16_t*)(lds + SK + (j0 + x) * LQ + d * 2)) * __expf(a_s[p0 + j0 + x] - M_last);
                u32x4 o; o.x = cvt_pk_bf16(kv[0], kv[1]); o.y = cvt_pk_bf16(kv[2], kv[3]); o.z = cvt_pk_bf16(kv[4], kv[5]); o.w = cvt_pk_bf16(kv[6], kv[7]);
                *(LAS u32x4*)(lds + SKT + d * LV + j0 * 2) = o; }
            { const int e = tid & 63, jg = tid >> 6, j0 = jg * 8; unsigned vv[8];
#pragma unroll
                for (int x = 0; x < 8; ++x) vv[x] = *(const LAS bf16_t*)(lds + SV + (j0 + x) * LV + e * 2);
                u32x4 o; o.x = vv[0] | (vv[1] << 16); o.y = vv[2] | (vv[3] << 16); o.z = vv[4] | (vv[5] << 16); o.w = vv[6] | (vv[7] << 16);
                *(LAS u32x4*)(lds + SVT + e * LV + j0 * 2) = o; }
            __syncthreads();
            if (emit) {
#pragma unroll
                for (int kk = 0; kk < 2; ++kk) {
                    const bf16x8 bp = *(const LAS bf16x8*)(lds + SP + i_loc * LV + (kk * 32 + fq * 8) * 2);
#pragma unroll
                    for (int t2 = 0; t2 < 2; ++t2) {
                        const bf16x8 av = *(const LAS bf16x8*)(lds + SVT + ((sub * 2 + t2) * 16 + fr) * LV + (kk * 32 + fq * 8) * 2);
                        hacc[t2] = __builtin_amdgcn_mfma_f32_16x16x32_bf16(av, bp, hacc[t2], 0, 0, 0);
                    }
                }
                float den = rs_s[i_loc] + rs_s[64 + i_loc] + w_inter * qn_s[i_loc];
                den = fmaxf(fabsf(den), __expf(-(B_s[p0 + i_loc] + M_i)));
                const float rden = __builtin_amdgcn_rcpf(den);
                const size_t orow = (size_t)scan_row(p0 + i_loc, b, dir);
#pragma unroll
                for (int t2 = 0; t2 < 2; ++t2) { const int e0 = (sub * 2 + t2) * 16 + 4 * fq;
                    u32x2 o; o.x = cvt_pk_bf16(hacc[t2][0] * rden, hacc[t2][1] * rden); o.y = cvt_pk_bf16(hacc[t2][2] * rden, hacc[t2][3] * rden);
                    *(u32x2*)(Hout + orow * D + h * HD + dvh * 64 + e0) = o; }
            }
#pragma unroll
            for (int te = 0; te < 4; ++te) cacc[te] = cacc[te] * decay;
#pragma unroll
            for (int kk = 0; kk < 2; ++kk) {
                const bf16x8 ak = *(const LAS bf16x8*)(lds + SKT + (wave * 16 + fr) * LV + (kk * 32 + fq * 8) * 2);
#pragma unroll
                for (int te = 0; te < 4; ++te) {
                    const bf16x8 bv = *(const LAS bf16x8*)(lds + SVT + (te * 16 + fr) * LV + (kk * 32 + fq * 8) * 2);
                    cacc[te] = __builtin_amdgcn_mfma_f32_16x16x32_bf16(ak, bv, cacc[te], 0, 0, 0);
                }
            }
#pragma unroll
            for (int te = 0; te < 4; ++te) { u32x2 o; o.x = cvt_pk_bf16(cacc[te][0], cacc[te][1]); o.y = cvt_pk_bf16(cacc[te][2], cacc[te][3]);
                *(LAS u32x2*)(lds + SC + (te * 16 + fr) * LQ + (wave * 16 + 4 * fq) * 2) = o; }
            if (tid < 128) { float s = 0.f;
#pragma unroll
                for (int g8 = 0; g8 < 8; ++g8) { const u32x4 w = *(const LAS u32x4*)(lds + SKT + tid * LV + g8 * 16);
                    s += (bf_lo(w.x) + bf_hi(w.x)) + (bf_lo(w.y) + bf_hi(w.y)) + (bf_lo(w.z) + bf_hi(w.z)) + (bf_lo(w.w) + bf_hi(w.w)); }
                n_s[tid] = decay * n_s[tid] + s; }
        }
    }
    __syncthreads();
}

__device__ __forceinline__ void phase_mix(const Params& p, int G) {
    const int tid = opaque_tid(), lane = tid & 63, wave = tid >> 6;
    const int gw = blockIdx.x * 8 + wave, NGW = G * 8;
    bf16_t* OZ = (bf16_t*)(p.ws + WS_V);
    const bf16_t* HF = (const bf16_t*)(p.ws + WS_HF); const bf16_t* HB = (const bf16_t*)(p.ws + WS_HB);
    const int c0 = lane * 16;
    const int per = (M_LAT + NGW - 1) / NGW;
    const int mbeg = gw * per, mend = min(mbeg + per, M_LAT);
    {
        f32x4 gh[4];
#pragma unroll
        for (int j = 0; j < 4; ++j) gh[j] = *(const f32x4*)(p.g_head + c0 + 4 * j);
        for (int m = mbeg; m < mend; m += 4) {
            u32x4 fr_[4][2], br_[4][2], zr[4][2];
#pragma unroll
            for (int q = 0; q < 4; ++q) { const size_t ro = (size_t)min(m + q, mend - 1) * D + c0;
                fr_[q][0] = *(const u32x4*)(HF + ro); fr_[q][1] = *(const u32x4*)(HF + ro + 8); br_[q][0] = *(const u32x4*)(HB + ro); br_[q][1] = *(const u32x4*)(HB + ro + 8);
                zr[q][0] = *(const u32x4*)(OZ + ro); zr[q][1] = *(const u32x4*)(OZ + ro + 8); }
#pragma unroll
            for (int q = 0; q < 4; ++q) { const int mm = m + q; if (mm >= mend) break;
                f32x4 hv[4], hb[4], oz[4];
                unpack8(fr_[q][0], hv[0], hv[1]); unpack8(fr_[q][1], hv[2], hv[3]); unpack8(br_[q][0], hb[0], hb[1]); unpack8(br_[q][1], hb[2], hb[3]);
                unpack8(zr[q][0], oz[0], oz[1]); unpack8(zr[q][1], oz[2], oz[3]);
                float ss = 0.f;
#pragma unroll
                for (int j = 0; j < 4; ++j) { hv[j] = hv[j] + hb[j]; ss += (hv[j][0] * hv[j][0] + hv[j][1] * hv[j][1]) + (hv[j][2] * hv[j][2] + hv[j][3] * hv[j][3]); }
                ss += __shfl_xor(ss, 1); ss += __shfl_xor(ss, 2); ss += __shfl_xor(ss, 4);
                const float rstd = rsqrtf(ss * (1.0f / HD) + EPS);
                f32x4 yb[4];
#pragma unroll
                for (int j = 0; j < 4; ++j) yb[j] = oz[j] * (hv[j] * rstd * gh[j]);
                *(u32x4*)(OZ + (size_t)mm * D + c0) = pack8(yb[0], yb[1]); *(u32x4*)(OZ + (size_t)mm * D + c0 + 8) = pack8(yb[2], yb[3]);
            }
        }
    }
}

__device__ __forceinline__ void phase_final(const Params& p, int G) {
    const int tid = opaque_tid(), lane = tid & 63, wave = tid >> 6;
    const int gw = blockIdx.x * 8 + wave, NGW = G * 8;
    f32x4 gf[4];
#pragma unroll
    for (int j = 0; j < 4; ++j) gf[j] = *(const f32x4*)(p.g_final + (lane + 64 * j) * 4);
    const int per = (M_LAT + NGW - 1) / NGW;
    const int mend = min((gw + 1) * per, M_LAT);
    for (int m = gw * per; m < mend; m += 4) {
        f32x4 v[4][4];
#pragma unroll
        for (int q = 0; q < 4; ++q) { const float* xr = p.out + (size_t)min(m + q, mend - 1) * D;
#pragma unroll
            for (int j = 0; j < 4; ++j) v[q][j] = *(const f32x4*)(xr + (lane + 64 * j) * 4); }
#pragma unroll
        for (int q = 0; q < 4; ++q) { if (m + q >= mend) break;
            float ss = 0.f;
#pragma unroll
            for (int j = 0; j < 4; ++j) ss += (v[q][j][0] * v[q][j][0] + v[q][j][1] * v[q][j][1]) + (v[q][j][2] * v[q][j][2] + v[q][j][3] * v[q][j][3]);
            const float rstd = rsqrtf(wave_sum(ss) * (1.0f / D) + EPS);
            float* xr = p.out + (size_t)(m + q) * D;
#pragma unroll
            for (int j = 0; j < 4; ++j) *(f32x4*)(xr + (lane + 64 * j) * 4) = v[q][j] * rstd * gf[j];
        }
    }
}

#define XB_TMO      128
#define XB_XCNT(j)  (256  + 64 * (j))
#define XB_XSUB(j)  (1280 + 64 * (j))
#define XB_XGEN(j)  (2304 + 64 * (j))
#define XB_TOP      3328
#define XB_TOPGEN   3392
#define XCD_BAR_WORDS 3456
#define XB_SPIN_CAP (1u << 18)
__device__ __forceinline__ unsigned xb_ld(unsigned* p)              { return __hip_atomic_load(p, __ATOMIC_RELAXED, __HIP_MEMORY_SCOPE_AGENT); }
__device__ __forceinline__ unsigned xb_add(unsigned* p, unsigned v) { return __hip_atomic_fetch_add(p, v, __ATOMIC_RELAXED, __HIP_MEMORY_SCOPE_AGENT); }
__device__ __forceinline__ unsigned xb_xcc_id() { return (unsigned)__builtin_amdgcn_s_getreg((3 << 11) | 20) & 0xFu; }
#define XB_SPIN(cond, bar) do { unsigned _sp = 0; while (cond) { __builtin_amdgcn_s_sleep(1); \
    if ((++_sp & 255u) == 0u) { if (xb_ld(&(bar)[XB_TMO])) break; if (_sp > XB_SPIN_CAP) { atomicAdd(&(bar)[XB_TMO], 1u); break; } } } } while (0)
struct XcdBarrier { unsigned* bar; unsigned x; volatile LAS unsigned* st; };
__device__ __forceinline__ XcdBarrier xcd_barrier_post(unsigned* bar, volatile LAS unsigned* st) {
    XcdBarrier b; b.bar = bar; b.x = xb_xcc_id(); b.st = st;
    if (threadIdx.x == 0) (void)xb_add(&bar[XB_XCNT(b.x)], 1u);
    return b;
}
__device__ __forceinline__ void xcd_barrier_complete(unsigned* bar, unsigned x, unsigned& nloc, unsigned& nx) {
    const unsigned G = gridDim.x * gridDim.y * gridDim.z;
    unsigned sum, cnt, mine, sp = 0u;
    for (;;) {
        sum = 0u; cnt = 0u; mine = 0u;
#pragma unroll
        for (unsigned j = 0; j < 16; ++j) { const unsigned c = xb_ld(&bar[XB_XCNT(j)]); sum += c; cnt += (c > 0u) ? 1u : 0u; mine = (j == x) ? c : mine; }
        if (sum == G) break;
        __builtin_amdgcn_s_sleep(1);
        if ((++sp & 255u) == 0u) { if (xb_ld(&bar[XB_TMO])) break; if (sp > XB_SPIN_CAP) { atomicAdd(&bar[XB_TMO], 1u); break; } }
    }
    nloc = mine > 0u ? mine : 1u; nx = cnt > 0u ? cnt : 1u;
}
__device__ __forceinline__ void xcd_barrier(const XcdBarrier& b) {
    asm volatile("s_waitcnt vmcnt(0)" ::: "memory");
    __syncthreads();
    if (threadIdx.x == 0) {
        unsigned* bar = b.bar;
        __builtin_amdgcn_s_waitcnt(0);
        unsigned nloc = b.st[0], nx = b.st[1];
        if (nloc == 0u) { xcd_barrier_complete(bar, b.x, nloc, nx); b.st[0] = nloc; b.st[1] = nx; }
        const unsigned old = xb_add(&bar[XB_XSUB(b.x)], 1u);
        const unsigned gen = old / nloc;
        if (old + 1u == (gen + 1u) * nloc) {
            __builtin_amdgcn_fence(__ATOMIC_RELEASE, "agent");
            asm volatile("s_waitcnt vmcnt(0)" ::: "memory");
            const unsigned og = xb_add(&bar[XB_TOP], 1u);
            const unsigned tg = og / nx;
            if (og + 1u == (tg + 1u) * nx) xb_add(&bar[XB_TOPGEN], 1u);
            else XB_SPIN(xb_ld(&bar[XB_TOPGEN]) == tg, bar);
            __builtin_amdgcn_fence(__ATOMIC_ACQUIRE, "agent");
            xb_add(&bar[XB_XGEN(b.x)], 1u);
            asm volatile("s_waitcnt vmcnt(0)" ::: "memory");
        } else {
            XB_SPIN(xb_ld(&bar[XB_XGEN(b.x)]) == gen, bar);
            __builtin_amdgcn_fence(__ATOMIC_ACQUIRE, "agent");
            asm volatile("s_waitcnt vmcnt(0)" ::: "memory");
        }
    }
    __syncthreads();
}

__global__ void __launch_bounds__(512, 2) fwd_megakernel(Params p) {
    extern __shared__ __attribute__((aligned(16))) unsigned char shm[];
    LAS unsigned char* lds = (LAS unsigned char*)shm;
    cg::grid_group grid = cg::this_grid();
    volatile LAS unsigned* bst = (volatile LAS unsigned*)(lds + LDS_STAGE);
    if (threadIdx.x < 2) bst[threadIdx.x] = 0u;
    __syncthreads();
    const XcdBarrier xbar = xcd_barrier_post((unsigned*)(p.ws + WS_BAR), bst);
    if (p.ws == nullptr) grid.sync();
#define GRID_SYNC() xcd_barrier(xbar)
#ifndef TIME_PHASE
#define TIME_PHASE -1
#endif
#define T_BEGIN(k) do { if (TIME_PHASE == (k) && threadIdx.x == 0) bst[4] = (unsigned)__builtin_amdgcn_s_memrealtime(); } while (0)
#define T_END(k) do { if (TIME_PHASE == (k) && threadIdx.x == 0) bst[5] = (unsigned)__builtin_amdgcn_s_memrealtime() - bst[4]; } while (0)
    const int G = gridDim.x;
    unsigned char* ws = p.ws;
    EpiPtrs E; E.ws = ws; E.out = p.out; E.x = p.x; E.bout = p.b_out; E.wconv = p.w_conv; E.bconv = p.b_conv;

    T_BEGIN(0); phase_prep(p, lds, G);
    GRID_SYNC(); T_END(0);
    T_BEGIN(1); phase_hx(p, G);
    GRID_SYNC(); T_END(1);
    T_BEGIN(2);
    {
        pg8::Gemm g{(const bf16_t*)(ws + WS_A0), (const bf16_t*)(ws + WS_WIN), M_ALL, N_STATE_PAD, D};
        pg8::StateOrder S; S.init(M_LAT, N_STATE_PAD, G, (int)blockIdx.x);
        Epi<0> e{E};
        pg8::gemm_phase(lds, g, S, e);
        const int total = 832 + 72, rounds = (total + G - 1) / G, full = total - (rounds - 1) * G;
        const int nshort = full < G ? G - full : 0;
        const int c = (int)blockIdx.x;
        phase_prep_rest(p, lds, nshort ? (c >= full ? c - full : -1) : c, nshort ? nshort : G);
    }
    GRID_SYNC(); T_END(2);
    T_BEGIN(3); phase_scan(p, lds, G);
    GRID_SYNC(); T_END(3);
    T_BEGIN(4);
    {
        pg8::Gemm g{(const bf16_t*)(ws + WS_A0), (const bf16_t*)(ws + WS_WIN) + (size_t)N_STATE_PAD * D, M_LAT, N_REST, D};
        pg8::StaticOrder S; S.init(M_LAT, N_REST, G, (int)blockIdx.x);
        Epi<1> e{E};
        pg8::gemm_phase(lds, g, S, e);
    }
    GRID_SYNC(); T_END(4);
    T_BEGIN(5); phase_mix(p, G);
    GRID_SYNC(); T_END(5);
    T_BEGIN(6);
    {
        pg8::Gemm g{(const bf16_t*)(ws + WS_K), (const bf16_t*)(ws + WS_WPA), M_LAT, D, D};
        pg8::PairOrder S; S.init(M_LAT, D, G, (int)blockIdx.x);
        Epi<2> e{E};
        pg8::gemm_phase(lds, g, S, e);
    }
    GRID_SYNC(); T_END(6);
    T_BEGIN(7);
    {
        pg8::StaticOrder S; S.init(M_LAT, D, G, (int)blockIdx.x);
        pg8::Gemm g{(const bf16_t*)(ws + WS_A0), (const bf16_t*)(ws + WS_WOUT), M_LAT, D, D}; Epi<4> e{E}; pg8::gemm_phase(lds, g, S, e);
    }
    GRID_SYNC(); T_END(7);
    T_BEGIN(8); phase_final(p, G); T_END(8);
    if (TIME_PHASE >= 0 && blockIdx.x == 0 && threadIdx.x == 0) { const unsigned t0 = (unsigned)__builtin_amdgcn_s_memrealtime(), w = 8u * bst[5]; while ((unsigned)__builtin_amdgcn_s_memrealtime() - t0 < w) __builtin_amdgcn_s_sleep(8); }
}

extern "C" void kernel_launch(void* const* d_in, const int* in_sizes, int n_in, void* d_out, int out_size, void* d_ws, size_t ws_size, hipStream_t stream) {
    static int grid_blocks = 0;
    if (!grid_blocks) {
        int dev = 0, cus = 0, per_cu = 0;
        hipGetDevice(&dev);
        hipDeviceGetAttribute(&cus, hipDeviceAttributeMultiprocessorCount, dev);
        if (hipFuncSetAttribute((const void*)fwd_megakernel, hipFuncAttributeMaxDynamicSharedMemorySize, LDS_BYTES) != hipSuccess) fprintf(stderr, "kernel_launch: hipFuncSetAttribute failed\n");
        if (hipOccupancyMaxActiveBlocksPerMultiprocessor(&per_cu, (const void*)fwd_megakernel, 512, LDS_BYTES) != hipSuccess || per_cu < 1) { fprintf(stderr, "kernel_launch: occupancy query gave %d\n", per_cu); per_cu = 1; }
        grid_blocks = cus * per_cu;
        if (grid_blocks > 256) grid_blocks = 256;
        if (ws_size < WS_END) fprintf(stderr, "kernel_launch: workspace too small: %zu < %zu\n", ws_size, (size_t)WS_END);
    }
    Params p{};
    p.x = (const float*)d_in[0]; p.c = (const float*)d_in[1]; p.ctx = (const float*)d_in[2]; p.c_ctx = (const float*)d_in[3];
    p.w_ada = (const float*)d_in[4]; p.b_ada = (const float*)d_in[5]; p.g_norm = (const float*)d_in[6]; p.w_in = (const float*)d_in[7]; p.b_in = (const float*)d_in[8];
    p.w_conv = (const float*)d_in[9]; p.b_conv = (const float*)d_in[10]; p.g_head = (const float*)d_in[11]; p.w_pa = (const float*)d_in[12]; p.w_pb = (const float*)d_in[13];
    p.w_out = (const float*)d_in[14]; p.b_out = (const float*)d_in[15]; p.g_final = (const float*)d_in[16];
    p.out = (float*)d_out; p.ws = (unsigned char*)d_ws;
    (void)hipMemsetAsync((unsigned char*)d_ws + WS_BAR, 0, XCD_BAR_WORDS * 4, stream);
    void* args[] = {&p};
    hipError_t e = hipLaunchCooperativeKernel((const void*)fwd_megakernel, dim3(grid_blocks), dim3(512), args, LDS_BYTES, stream);
    if (e != hipSuccess) fprintf(stderr, "cooperative launch failed: %s (grid %d)\n", hipGetErrorString(e), grid_blocks);
}
```
